# Optimizing an MI355X kernel written in HIP

```python
import jax, jax.numpy as jnp
from jax import lax
import numpy as np

D_MODEL = 2048
BATCH = 4
SEQ = 4096
DEPTH = 1

PLE_DIM = 256
D_MIX = D_MODEL
D_GLA = D_MIX // 2
D_SB = D_MIX - D_GLA
GLA_HEADS = 4
GLA_DK = (D_GLA // 2) // GLA_HEADS
GLA_DV = D_GLA // GLA_HEADS
GLA_GATE_RANK = 16
GLA_TAU = 16.0
GLA_CHUNK = 64
SB_HEADS = 8
SB_DH = D_SB // SB_HEADS
SB_BLOCK = 128
EPS = 1e-6

GLA_QK = GLA_HEADS * GLA_DK
SPLITS = [GLA_QK, GLA_QK, D_GLA, D_GLA, GLA_GATE_RANK, D_SB, D_SB, D_SB, D_SB]
D_IN = sum(SPLITS)

kernel_name = "hybrid_gla_stickbreaking_parallel_heads"


def rmsnorm(x, g):
    xf = x.astype(jnp.float32)
    return xf * lax.rsqrt(jnp.mean(xf * xf, axis=-1, keepdims=True) + EPS) * g.astype(jnp.float32)


def gla_chunked(q, k, v, log_a):
    B, S, H, dk = q.shape
    dv = v.shape[-1]
    C = GLA_CHUNK
    n = S // C

    def to_chunks(t):
        return t.astype(jnp.float32).reshape(B, n, C, H, t.shape[-1]).transpose(1, 0, 3, 2, 4)

    qc = to_chunks(q) * (dk ** -0.5)
    kc = to_chunks(k)
    vc = to_chunks(v)
    bc = jnp.cumsum(to_chunks(log_a), axis=3)
    causal = jnp.tril(jnp.ones((C, C), dtype=bool))[None, None, :, :, None]

    def step(state, inp):
        qi, ki, vi, bi = inp
        inter = jnp.einsum('bhcd,bhde->bhce', qi * jnp.exp(bi), state)
        diff = bi[:, :, :, None, :] - bi[:, :, None, :, :]
        decay = jnp.exp(jnp.where(causal, diff, -jnp.inf))
        scores = jnp.einsum('bhid,bhjd,bhijd->bhij', qi, ki, decay)
        intra = jnp.einsum('bhij,bhje->bhie', scores, vi)
        b_last = bi[:, :, -1:, :]
        new_state = state * jnp.exp(b_last)[:, :, 0, :, None] + jnp.einsum(
            'bhcd,bhce->bhde', ki * jnp.exp(b_last - bi), vi)
        return new_state, inter + intra

    s0 = jnp.zeros((B, H, dk, dv), jnp.float32)
    _, out = lax.scan(step, s0, (qc, kc, vc, bc))
    return out.transpose(1, 0, 3, 2, 4).reshape(B, S, H, dv)


def stick_breaking(q, k, v):
    S = q.shape[2]
    scale = q.shape[-1] ** -0.5
    qf, kf, vf = (t.astype(jnp.float32) for t in (q, k, v))
    outs = []
    for blk in range(S // SB_BLOCK):
        t0 = blk * SB_BLOCK
        t1 = t0 + SB_BLOCK
        z = jnp.einsum('bhtd,bhsd->bhts', qf[:, :, t0:t1], kf[:, :, :t1]) * scale
        t_idx = jnp.arange(t0, t1)[:, None]
        s_idx = jnp.arange(t1)[None, :]
        before = s_idx < t_idx
        log_keep = jnp.where(before, jax.nn.log_sigmoid(-z), 0.0)
        suffix = lax.cumsum(log_keep, axis=3, reverse=True) - log_keep
        w = jnp.where(before, jnp.exp(jax.nn.log_sigmoid(z) + suffix), 0.0)
        outs.append(jnp.einsum('bhts,bhsd->bhtd', w, vf[:, :, :t1]))
    return jnp.concatenate(outs, axis=2)


def setup_inputs(seed: int = 0) -> dict:
    key = jax.random.key(seed)
    ks = jax.random.split(key, 12)
    f32 = jnp.float32
    x = jax.random.normal(ks[0], (BATCH, SEQ, D_MODEL), f32)
    p = jax.random.normal(ks[1], (DEPTH, BATCH, SEQ, PLE_DIM), f32)
    g_pre = 1.0 + 0.02 * jax.random.normal(ks[2], (DEPTH, D_MODEL), f32)
    w_in = jax.random.normal(ks[3], (DEPTH, D_MODEL, D_IN), f32) * D_MODEL ** -0.5
    w_a2 = jax.random.normal(ks[4], (DEPTH, GLA_GATE_RANK, GLA_QK), f32) * GLA_GATE_RANK ** -0.5
    b_a = 0.1 * jax.random.normal(ks[5], (DEPTH, GLA_QK), f32)
    g_gla_head = 1.0 + 0.02 * jax.random.normal(ks[6], (DEPTH, GLA_DV), f32)
    w_out = jax.random.normal(ks[7], (DEPTH, D_MIX, D_MODEL), f32) * D_MIX ** -0.5
    g_post = 1.0 + 0.02 * jax.random.normal(ks[8], (DEPTH, D_MODEL), f32)
    w_ple_gate = jax.random.normal(ks[9], (DEPTH, D_MODEL, D_MODEL), f32) * D_MODEL ** -0.5
    b_ple_gate = 0.02 * jax.random.normal(ks[10], (DEPTH, D_MODEL), f32)
    w_ple_proj = jax.random.normal(ks[11], (DEPTH, PLE_DIM, D_MODEL), f32) * PLE_DIM ** -0.5
    return {"x": x, "p": p, "g_pre": g_pre, "w_in": w_in, "w_a2": w_a2, "b_a": b_a,
            "g_gla_head": g_gla_head, "w_out": w_out, "g_post": g_post,
            "w_ple_gate": w_ple_gate, "b_ple_gate": b_ple_gate, "w_ple_proj": w_ple_proj}


def reference(x, p, g_pre, w_in, w_a2, b_a, g_gla_head, w_out, g_post,
              w_ple_gate, b_ple_gate, w_ple_proj):
    B, S, _ = x.shape
    out_dtype = x.dtype
    h_res = x.astype(jnp.float32)
    offsets = np.cumsum(SPLITS)[:-1].tolist()
    for i in range(DEPTH):
        h = rmsnorm(h_res, g_pre[i])
        u = h @ w_in[i].astype(jnp.float32)
        (gq, gk, gv, g_gate, g_lr, sq, sk, sv, s_gate) = jnp.split(u, offsets, axis=-1)

        log_a = jax.nn.log_sigmoid(g_lr @ w_a2[i].astype(jnp.float32) + b_a[i]) / GLA_TAU
        o_gla = gla_chunked(gq.reshape(B, S, GLA_HEADS, GLA_DK),
                            gk.reshape(B, S, GLA_HEADS, GLA_DK),
                            gv.reshape(B, S, GLA_HEADS, GLA_DV),
                            log_a.reshape(B, S, GLA_HEADS, GLA_DK))
        o_gla = rmsnorm(o_gla, g_gla_head[i]).reshape(B, S, D_GLA) * jax.nn.silu(g_gate)

        def heads(t):
            return t.reshape(B, S, SB_HEADS, SB_DH).transpose(0, 2, 1, 3)
        o_sb = stick_breaking(heads(sq), heads(sk), heads(sv))
        o_sb = o_sb.transpose(0, 2, 1, 3).reshape(B, S, D_SB) * jax.nn.silu(s_gate)

        mix = jnp.concatenate([o_gla, o_sb], axis=-1) @ w_out[i].astype(jnp.float32)
        h_res = h_res + rmsnorm(mix, g_post[i])

        gate = jax.nn.sigmoid(h_res @ w_ple_gate[i].astype(jnp.float32) + b_ple_gate[i])
        h_res = h_res + gate * (p[i].astype(jnp.float32) @ w_ple_proj[i].astype(jnp.float32))
    return h_res.astype(out_dtype)
```

```cpp
#include <hip/hip_runtime.h>
#include <cstdio>
#include <cstdint>
namespace pg8 {
#define PG8_LAS __attribute__((address_space(3)))
typedef unsigned short bf16_t;
typedef short bf16x8 __attribute__((ext_vector_type(8)));
typedef float f32x4 __attribute__((ext_vector_type(4)));
typedef unsigned u32x4 __attribute__((ext_vector_type(4)));
constexpr int BM = 256, BK = 64, HALF = 128, HTB = HALF * BK * 2  , STAGE_BYTES = 8 * HTB, NXCD = 8, WGM = 8;

__host__ __device__ __forceinline__ int lds_byte(int r, int c) { const int st = (r >> 4) * 2 + (c >> 5), rr = r & 15, cc = c & 31, ob = rr * 64 + cc * 2; return st * 1024 + (ob ^ (((ob >> 9) & 1) << 5)); }
__host__ __device__ __forceinline__ void stage_rc(int b, int& R, int& C) { const int st = b / 1024, sb = b % 1024, swz = sb ^ (((sb >> 9) & 1) << 5); R = (st >> 1) * 16 + swz / 64; C = (st & 1) * 32 + (swz % 64) / 2; }
__host__ __device__ __forceinline__ int perm32(int rho) { const int n = rho >> 4, i = rho & 15; return 8 * (i >> 2) + 4 * n + (i & 3); }

struct Unit { int pm, pn; };
struct Gemm { const bf16_t* A; const bf16_t* Bt; int M, N, K; };

struct StaticOrder {
    int nM, nN, nwg, G, c;
    __host__ __device__ void init(int M, int N, int G_, int c_) { nM = M / BM; nN = N / BM; nwg = nM * nN; G = G_; c = c_; }
    __host__ __device__ bool next(int i, Unit& u) const {
        const long L = (long)i * G + c; if (L >= nwg) return false;
        int wgid = (int)L; { const int q = nwg / NXCD, r = nwg % NXCD, xcd = wgid % NXCD, off = wgid / NXCD; wgid = (xcd < r ? xcd * (q + 1) : r * (q + 1) + (xcd - r) * q) + off; }
        const int nig = WGM * nN, gid = wgid / nig, fm = gid * WGM, gsz = (nM - fm) < WGM ? (nM - fm) : WGM;
        u.pm = fm + ((wgid % nig) % gsz); u.pn = (wgid % nig) / gsz; return true;
    }
    __device__ __forceinline__ void a_ready(const Unit&) const {}
    __device__ __forceinline__ void done(const Unit&) const {}
};

__device__ __forceinline__ unsigned cvt_pk_bf16(float lo, float hi) { unsigned r; asm volatile("v_cvt_pk_bf16_f32 %0, %1, %2" : "=v"(r) : "v"(lo), "v"(hi)); return r; }
typedef float f32x2 __attribute__((ext_vector_type(2)));
__device__ __forceinline__ f32x2 gelu_pk(f32x2 v) {
    const f32x2 av = __builtin_elementwise_abs(v), d = av * 0.2316418882f + 1.0f;
    f32x2 t; t.x = __builtin_amdgcn_rcpf(d.x); t.y = __builtin_amdgcn_rcpf(d.y);
    f32x2 q = t * 0.5307027145f + (-0.7265760135f); q = q * t + 0.7107068705f; q = q * t + (-0.142248368f); q = q * t + 0.127414796f; q = q * t;
    const f32x2 s = (v * v) * (-0.72134752044f);
    f32x2 e; e.x = __builtin_amdgcn_exp2f(s.x); e.y = __builtin_amdgcn_exp2f(s.y);
    const f32x2 m = v * (q * e), r = v - m;
    f32x2 o; o.x = v.x < 0.f ? m.x : r.x; o.y = v.y < 0.f ? m.y : r.y; return o;
}

template <int ACT  > struct EpiBf16 {
    static constexpr bool PERM = true, AFTER_DRAIN = false; static_assert(ACT == 0 || ACT == 1, "EpiBf16: ACT is 0 (none) or 1 (gelu_pk)");
    bf16_t* O; int ldc; const float* bias; int split_cols; size_t split_stride; float scale0;
    __device__ __forceinline__ void operator()(const f32x4 (&acc)[2][2][4][2], const Unit& u, int wr, int wc, int fr, int fq) const {
        const int row0 = u.pm * BM + wr * 64 + fr; int colt = u.pn * BM; bf16_t* base = O;
        float sc = 1.f; if (split_cols) { const int t = colt / split_cols; base += (size_t)t * split_stride; colt -= t * split_cols; if (t == 0) sc = scale0; }
        const int col0 = colt + wc * 32 + 8 * fq, bcol0 = u.pn * BM + wc * 32 + 8 * fq;
        f32x4 bv[2][2];
#pragma unroll
        for (int bj = 0; bj < 2; ++bj)
#pragma unroll
            for (int n = 0; n < 2; ++n) bv[bj][n] = bias ? *(const f32x4*)(bias + bcol0 + bj * HALF + 4 * n) : (f32x4){0.f, 0.f, 0.f, 0.f};
#pragma unroll
        for (int ai = 0; ai < 2; ++ai)
#pragma unroll
            for (int m = 0; m < 4; ++m) { bf16_t* rowp = base + (size_t)(row0 + ai * HALF + m * 16) * ldc + col0;
#pragma unroll
                for (int bj = 0; bj < 2; ++bj) { f32x4 v0 = acc[ai][bj][m][0] + bv[bj][0], v1 = acc[ai][bj][m][1] + bv[bj][1];
                    if (ACT == 1) { f32x2 a = gelu_pk((f32x2){v0[0], v0[1]}), b = gelu_pk((f32x2){v0[2], v0[3]}), c = gelu_pk((f32x2){v1[0], v1[1]}), d = gelu_pk((f32x2){v1[2], v1[3]});
                        v0 = (f32x4){a.x, a.y, b.x, b.y}; v1 = (f32x4){c.x, c.y, d.x, d.y}; }
                    v0 = v0 * sc; v1 = v1 * sc; u32x4 w; w.x = cvt_pk_bf16(v0[0], v0[1]); w.y = cvt_pk_bf16(v0[2], v0[3]); w.z = cvt_pk_bf16(v1[0], v1[1]); w.w = cvt_pk_bf16(v1[2], v1[3]);
                    *(u32x4*)(rowp + bj * HALF) = w; } }
    }
};
struct EpiU {
    static constexpr bool PERM = true, AFTER_DRAIN = false;
    bf16_t* O; int ldc; const float* rs;
    __device__ __forceinline__ void operator()(const f32x4 (&acc)[2][2][4][2], const Unit& u, int wr, int wc, int fr, int fq) const {
        const int row0 = u.pm * BM + wr * 64 + fr; const int col0 = u.pn * BM + wc * 32 + 8 * fq;
#pragma unroll
        for (int ai = 0; ai < 2; ++ai)
#pragma unroll
            for (int m = 0; m < 4; ++m) { const int row = row0 + ai * HALF + m * 16; const float sc = rs[row]; bf16_t* rowp = O + (size_t)row * ldc + col0;
#pragma unroll
                for (int bj = 0; bj < 2; ++bj) { const f32x4 v0 = acc[ai][bj][m][0] * sc, v1 = acc[ai][bj][m][1] * sc;
                    u32x4 w; w.x = cvt_pk_bf16(v0[0], v0[1]); w.y = cvt_pk_bf16(v0[2], v0[3]); w.z = cvt_pk_bf16(v1[0], v1[1]); w.w = cvt_pk_bf16(v1[2], v1[3]);
                    *(u32x4*)(rowp + bj * HALF) = w; } }
    }
};
struct EpiF32 {
    static constexpr bool PERM = false, AFTER_DRAIN = false;
    float* C; int ldc;
    __device__ __forceinline__ void operator()(const f32x4 (&acc)[2][2][4][2], const Unit& u, int wr, int wc, int fr, int fq) const {
        const int row0 = u.pm * BM + wr * 64 + fr, col0 = u.pn * BM + wc * 32 + 4 * fq;
#pragma unroll
        for (int ai = 0; ai < 2; ++ai)
#pragma unroll
            for (int m = 0; m < 4; ++m) { float* rowp = C + (size_t)(row0 + ai * HALF + m * 16) * ldc + col0;
#pragma unroll
                for (int bj = 0; bj < 2; ++bj)
#pragma unroll
                    for (int n = 0; n < 2; ++n) *(f32x4*)(rowp + bj * HALF + n * 16) = acc[ai][bj][m][n]; }
    }
};
struct EpiFinal {
    static constexpr bool PERM = false, AFTER_DRAIN = false;
    float* HO; const bf16_t* P; const float* bg; int ldc;
    __device__ __forceinline__ void operator()(const f32x4 (&acc)[2][2][4][2], const Unit& u, int wr, int wc, int fr, int fq) const {
        typedef unsigned u32x2v __attribute__((ext_vector_type(2)));
        const int row0 = u.pm * BM + wr * 64 + fr, col0 = u.pn * BM + wc * 32 + 4 * fq;
        f32x4 bv[2][2];
#pragma unroll
        for (int bj = 0; bj < 2; ++bj)
#pragma unroll
            for (int n = 0; n < 2; ++n) bv[bj][n] = *(const f32x4*)(bg + col0 + bj * HALF + n * 16);
#pragma unroll
        for (int ai = 0; ai < 2; ++ai)
#pragma unroll
            for (int m = 0; m < 4; ++m) { const size_t off = (size_t)(row0 + ai * HALF + m * 16) * ldc + col0;
#pragma unroll
                for (int bj = 0; bj < 2; ++bj)
#pragma unroll
                    for (int n = 0; n < 2; ++n) { const size_t o2 = off + bj * HALF + n * 16;
                        const f32x4 h = *(const f32x4*)(HO + o2); const u32x2v pw = *(const u32x2v*)(P + o2);
                        const f32x4 a = acc[ai][bj][m][n] + bv[bj][n];
                        f32x4 pv; pv[0] = __uint_as_float(pw.x << 16); pv[1] = __uint_as_float(pw.x & 0xffff0000u); pv[2] = __uint_as_float(pw.y << 16); pv[3] = __uint_as_float(pw.y & 0xffff0000u);
                        f32x4 o;
#pragma unroll
                        for (int j = 0; j < 4; ++j) o[j] = h[j] + pv[j] / (1.0f + __expf(-a[j]));
                        *(f32x4*)(HO + o2) = o; }
                if (m & 1) asm volatile("" ::: "memory"); }
    }
};
template <class Epi, class Sched, bool ALIGN_EPI = false, bool SP2 = false>
__device__ __forceinline__ void gemm_phase(PG8_LAS unsigned char* lds, const Gemm g, const Sched& S, const Epi& E) {
    int tid_ = threadIdx.x; asm volatile("" : "+v"(tid_));
    const int tid = tid_, wid = __builtin_amdgcn_readfirstlane(tid >> 6), lane = tid & 63, wr = wid >> 2, wc = wid & 3, fr = lane & 15, fq = lane >> 4;
    const int K = g.K, nt = K / BK;
    unsigned voffA[2], voffB[2];
#pragma unroll
    for (int i = 0; i < 2; ++i) { int R, C; stage_rc(tid * 16 + i * 8192, R, C); const int Rb = Epi::PERM ? ((R & ~31) + perm32(R & 31)) : R;
        voffA[i] = (unsigned)(R * K + C) * 2u; voffB[i] = (unsigned)(Rb * K + C) * 2u; }
    const size_t kstep = (size_t)(BK * 2);
    const size_t hstep = (size_t)HALF * K * 2;
    const size_t tstep = 2 * hstep;
    const unsigned ldsw = (unsigned)wid * 1024u;
    const int aoff = lds_byte(wr * 64 + fr, fq * 8), boff = lds_byte(wc * 32 + fr, fq * 8);
#define PG8_SA(b, h) (((b) * 2 + (h)) * HTB)
#define PG8_SB(b, h) ((4 + (b) * 2 + (h)) * HTB)
#define PG8_STAGE(bufoff, gbase, voff) do { _Pragma("unroll") for (int _i = 0; _i < 2; ++_i) \
        __builtin_amdgcn_global_load_lds((const unsigned*)((const char*)(gbase) + (voff)[_i]), (PG8_LAS unsigned*)(lds + (bufoff) + ldsw + _i * 8192), 16, 0, 0); } while (0)
#define PG8_LDA(dst, b, h) do { _Pragma("unroll") for (int m = 0; m < 4; ++m) _Pragma("unroll") for (int k = 0; k < 2; ++k) dst[m][k] = *(const PG8_LAS bf16x8*)(lds + PG8_SA(b, h) + aoff + m * 2048 + k * 1024); } while (0)
#define PG8_LDB(dst, b, h) do { _Pragma("unroll") for (int n = 0; n < 2; ++n) _Pragma("unroll") for (int k = 0; k < 2; ++k) dst[n][k] = *(const PG8_LAS bf16x8*)(lds + PG8_SB(b, h) + boff + n * 2048 + k * 1024); } while (0)
#define PG8_MMA(ai, bj, At, Bt) do { __builtin_amdgcn_s_setprio(1); _Pragma("unroll") for (int m = 0; m < 4; ++m) _Pragma("unroll") for (int n = 0; n < 2; ++n) _Pragma("unroll") for (int k = 0; k < 2; ++k) \
        acc[ai][bj][m][n] = __builtin_amdgcn_mfma_f32_16x16x32_bf16(Bt[n][k], At[m][k], acc[ai][bj][m][n], 0, 0, 0); __builtin_amdgcn_s_setprio(0); } while (0)
#define PG8_WAIT_V(n) asm volatile("s_waitcnt vmcnt(" #n ")" ::: "memory")
#define PG8_WAIT_L(n) asm volatile("s_waitcnt lgkmcnt(" #n ")" ::: "memory")
#define PG8_BAR __builtin_amdgcn_s_barrier()
#define PG8_SCHED __builtin_amdgcn_sched_barrier(0)
    Unit cur, nxt; int ui = 0;
    if (!S.next(0, cur)) return;
    f32x4 acc[2][2][4][2];
#pragma unroll
    for (int a = 0; a < 2; ++a)
#pragma unroll
        for (int b = 0; b < 2; ++b)
#pragma unroll
            for (int m = 0; m < 4; ++m)
#pragma unroll
                for (int n = 0; n < 2; ++n) acc[a][b][m][n] = (f32x4){0.f, 0.f, 0.f, 0.f};
    bf16x8 At[4][2], B0[2][2], B1[2][2];
    const char* cA = (const char*)g.A + (size_t)cur.pm * tstep; const char* cB = (const char*)g.Bt + (size_t)cur.pn * tstep;
    S.a_ready(cur);
    if constexpr (SP2) {
        PG8_STAGE(PG8_SB(0, 0), cB, voffB); PG8_STAGE(PG8_SB(0, 1), cB + hstep, voffB); PG8_STAGE(PG8_SA(0, 0), cA, voffA); PG8_STAGE(PG8_SA(0, 1), cA + hstep, voffA);
        if (wr == 1) PG8_BAR;
        PG8_WAIT_V(2); PG8_BAR;
        PG8_STAGE(PG8_SB(1, 0), cB + kstep, voffB); PG8_STAGE(PG8_SA(1, 0), cA + kstep, voffA); PG8_STAGE(PG8_SB(1, 1), cB + hstep + kstep, voffB);
        PG8_WAIT_V(6); PG8_BAR;
    } else {
        PG8_STAGE(PG8_SB(0, 0), cB, voffB); PG8_STAGE(PG8_SA(0, 0), cA, voffA); PG8_STAGE(PG8_SB(0, 1), cB + hstep, voffB); PG8_STAGE(PG8_SA(0, 1), cA + hstep, voffA);
        if (wr == 1) PG8_BAR;
        PG8_WAIT_V(4); PG8_BAR;
        PG8_STAGE(PG8_SB(1, 0), cB + kstep, voffB); PG8_STAGE(PG8_SA(1, 0), cA + kstep, voffA); PG8_STAGE(PG8_SB(1, 1), cB + hstep + kstep, voffB);
        PG8_WAIT_V(6); PG8_BAR;
    }
    for (;;) {
        const bool has_next = S.next(ui + 1, nxt);
        const char* nA = has_next ? (const char*)g.A + (size_t)nxt.pm * tstep : cA; const char* nB = has_next ? (const char*)g.Bt + (size_t)nxt.pn * tstep : cB;
        for (int t = 0; t < nt; t += 2) {
            const bool last = (t == nt - 2);
            const char* a1 = cA + (size_t)(t + 1) * kstep;
            const char* a2 = last ? nA : cA + (size_t)(t + 2) * kstep; const char* b2 = last ? nB : cB + (size_t)(t + 2) * kstep;
            const char* a3 = a2 + kstep; const char* b3 = b2 + kstep;
            if (last && has_next) S.a_ready(nxt);
            if constexpr (SP2) {
            PG8_LDB(B0, 0, 0); PG8_LDB(B1, 0, 1); PG8_SCHED; PG8_LDA(At, 0, 0); PG8_STAGE(PG8_SA(1, 1), a1 + hstep, voffA);
            PG8_WAIT_V(8); PG8_WAIT_L(0); PG8_BAR; PG8_MMA(0, 0, At, B0); PG8_MMA(0, 1, At, B1); PG8_BAR; PG8_SCHED;
            PG8_LDA(At, 0, 1); PG8_STAGE(PG8_SB(0, 0), b2, voffB); PG8_STAGE(PG8_SB(0, 1), b2 + hstep, voffB); PG8_STAGE(PG8_SA(0, 0), a2, voffA);
            PG8_WAIT_V(8); PG8_WAIT_L(0); PG8_BAR; PG8_MMA(1, 0, At, B0); PG8_MMA(1, 1, At, B1); PG8_BAR; PG8_SCHED;
            PG8_LDB(B0, 1, 0); PG8_LDB(B1, 1, 1); PG8_SCHED; PG8_LDA(At, 1, 0); PG8_STAGE(PG8_SA(0, 1), a2 + hstep, voffA);
            PG8_WAIT_V(8); PG8_WAIT_L(0); PG8_BAR; PG8_MMA(0, 0, At, B0); PG8_MMA(0, 1, At, B1); PG8_BAR; PG8_SCHED;
            PG8_LDA(At, 1, 1); PG8_STAGE(PG8_SB(1, 0), b3, voffB); PG8_STAGE(PG8_SB(1, 1), b3 + hstep, voffB); PG8_STAGE(PG8_SA(1, 0), a3, voffA);
            PG8_WAIT_V(8); PG8_WAIT_L(0); PG8_BAR; PG8_MMA(1, 0, At, B0); PG8_MMA(1, 1, At, B1); PG8_BAR; PG8_SCHED;
            } else {
            PG8_LDB(B0, 0, 0); PG8_SCHED; PG8_LDA(At, 0, 0); PG8_STAGE(PG8_SA(1, 1), a1 + hstep, voffA);
            PG8_WAIT_L(8); PG8_BAR; PG8_WAIT_L(0); PG8_MMA(0, 0, At, B0); PG8_BAR; PG8_SCHED;
            PG8_LDB(B1, 0, 1); PG8_STAGE(PG8_SB(0, 0), b2, voffB);
            PG8_BAR; PG8_WAIT_L(0); PG8_MMA(0, 1, At, B1); PG8_BAR;
            PG8_LDA(At, 0, 1); PG8_STAGE(PG8_SA(0, 0), a2, voffA);
            PG8_BAR; PG8_WAIT_L(0); PG8_MMA(1, 0, At, B0); PG8_BAR; PG8_SCHED;
            PG8_STAGE(PG8_SB(0, 1), b2 + hstep, voffB);
            PG8_WAIT_V(6); PG8_BAR; PG8_MMA(1, 1, At, B1); PG8_BAR;
            PG8_LDB(B0, 1, 0); PG8_SCHED; PG8_LDA(At, 1, 0); PG8_STAGE(PG8_SA(0, 1), a2 + hstep, voffA);
            PG8_WAIT_L(8); PG8_BAR; PG8_WAIT_L(0); PG8_MMA(0, 0, At, B0); PG8_BAR; PG8_SCHED;
            PG8_LDB(B1, 1, 1); PG8_STAGE(PG8_SB(1, 0), b3, voffB);
            PG8_BAR; PG8_WAIT_L(0); PG8_MMA(0, 1, At, B1); PG8_BAR;
            PG8_LDA(At, 1, 1); PG8_STAGE(PG8_SA(1, 0), a3, voffA);
            PG8_BAR; PG8_WAIT_L(0); PG8_MMA(1, 0, At, B0); PG8_BAR; PG8_SCHED;
            PG8_STAGE(PG8_SB(1, 1), b3 + hstep, voffB);
            PG8_WAIT_V(6); PG8_BAR; PG8_MMA(1, 1, At, B1); PG8_BAR;
            }
        }
        if constexpr (ALIGN_EPI) { if (wr == 0) PG8_BAR; }
        if constexpr (!Epi::AFTER_DRAIN) { E(acc, cur, wr, wc, fr, fq); S.done(cur); }
        if (!has_next) break;
#pragma unroll
        for (int a = 0; a < 2; ++a)
#pragma unroll
            for (int b = 0; b < 2; ++b)
#pragma unroll
                for (int m = 0; m < 4; ++m)
#pragma unroll
                    for (int n = 0; n < 2; ++n) acc[a][b][m][n] = (f32x4){0.f, 0.f, 0.f, 0.f};
        cur = nxt; cA = nA; cB = nB; ++ui;
        if constexpr (ALIGN_EPI) { if (wr == 1) PG8_BAR; }
    }
    PG8_WAIT_V(0);
    if constexpr (!ALIGN_EPI) { if (wr == 0) PG8_BAR; }
    PG8_BAR;
    if constexpr (Epi::AFTER_DRAIN) { E.fused(acc, cur, wr, wc, fr, fq, lds, wid, lane); S.done(cur); }
#undef PG8_SA
#undef PG8_SB
#undef PG8_STAGE
#undef PG8_LDA
#undef PG8_LDB
#undef PG8_MMA
#undef PG8_WAIT_V
#undef PG8_WAIT_L
#undef PG8_BAR
#undef PG8_SCHED
}
}
#define GAS __attribute__((address_space(1)))
#define LAS __attribute__((address_space(3)))
typedef unsigned short bf16;
typedef unsigned v4u __attribute__((ext_vector_type(4)));
typedef float f32x4 __attribute__((ext_vector_type(4)));
typedef short bf16x8 __attribute__((ext_vector_type(8)));
typedef GAS unsigned gu32;
typedef GAS unsigned long long gu64;
#define RLX_AGENT __ATOMIC_RELAXED, __HIP_MEMORY_SCOPE_AGENT
#define LDS_WAIT() asm volatile("s_waitcnt lgkmcnt(0)" ::: "memory")
#define VM_WAIT() asm volatile("s_waitcnt vmcnt(0)" ::: "memory")
__device__ __forceinline__ unsigned long long rt() { return __builtin_amdgcn_s_memrealtime(); }
__device__ __forceinline__ unsigned f2bf(float f) { unsigned u = __builtin_bit_cast(unsigned, f); return (u + 0x7fffu + ((u >> 16) & 1u)) >> 16; }
__device__ __forceinline__ unsigned pk2(float lo, float hi) { return f2bf(lo) | (f2bf(hi) << 16); }

#define XB_TMO      128
#define XB_XCNT(j)  (256  + 64 * (j))
#define XB_XSUB(j)  (1280 + 64 * (j))
#define XB_XGEN(j)  (2304 + 64 * (j))
#define XB_TOP      3328
#define XB_TOPGEN   3392
#define XCD_BAR_WORDS 3456
#define XB_SPIN_CAP (1u << 18)

__device__ __forceinline__ unsigned xb_ld(unsigned* p)              { return __hip_atomic_load(p, __ATOMIC_RELAXED, __HIP_MEMORY_SCOPE_AGENT); }
__device__ __forceinline__ unsigned xb_add(unsigned* p, unsigned v) { return __hip_atomic_fetch_add(p, v, __ATOMIC_RELAXED, __HIP_MEMORY_SCOPE_AGENT); }
__device__ __forceinline__ unsigned xb_xcc_id() { return (unsigned)__builtin_amdgcn_s_getreg((3 << 11) | 20) & 0xFu; }
#define XB_SPIN(cond, bar) do { unsigned _sp = 0; while (cond) { __builtin_amdgcn_s_sleep(1); \
    if ((++_sp & 255u) == 0u) { if (xb_ld(&(bar)[XB_TMO])) break; if (_sp > XB_SPIN_CAP) { atomicAdd(&(bar)[XB_TMO], 1u); break; } } } } while (0)

struct XcdBarrier {
    unsigned* bar; unsigned x;
    volatile LAS unsigned* st;
};

__device__ __forceinline__ XcdBarrier xcd_barrier_post(unsigned* bar, volatile LAS unsigned* st) {
    XcdBarrier b; b.bar = bar; b.x = xb_xcc_id(); b.st = st;
    if (threadIdx.x == 0) (void)xb_add(&bar[XB_XCNT(b.x)], 1u);
    return b;
}
__device__ __forceinline__ void xcd_barrier_complete(unsigned* bar, unsigned x, unsigned& nloc, unsigned& nx) {
    const unsigned G = gridDim.x * gridDim.y * gridDim.z;
    unsigned sum, cnt, mine, sp = 0u;
    for (;;) {
        sum = 0u; cnt = 0u; mine = 0u;
#pragma unroll
        for (unsigned j = 0; j < 16; ++j) { const unsigned c = xb_ld(&bar[XB_XCNT(j)]); sum += c; cnt += (c > 0u) ? 1u : 0u; mine = (j == x) ? c : mine; }
        if (sum == G) break;
        __builtin_amdgcn_s_sleep(1);
        if ((++sp & 255u) == 0u) { if (xb_ld(&bar[XB_TMO])) break; if (sp > XB_SPIN_CAP) { atomicAdd(&bar[XB_TMO], 1u); break; } }
    }
    nloc = mine > 0u ? mine : 1u; nx = cnt > 0u ? cnt : 1u;
}

__device__ __forceinline__ void xcd_barrier(const XcdBarrier& b) {
    asm volatile("s_waitcnt vmcnt(0)" ::: "memory");
    __syncthreads();
    if (threadIdx.x == 0) {
        unsigned* bar = b.bar;
        __builtin_amdgcn_s_waitcnt(0);
        unsigned nloc = b.st[0], nx = b.st[1];
        if (nloc == 0u) { xcd_barrier_complete(bar, b.x, nloc, nx); b.st[0] = nloc; b.st[1] = nx; }
        const unsigned old = xb_add(&bar[XB_XSUB(b.x)], 1u);
        const unsigned gen = old / nloc;
        if (old + 1u == (gen + 1u) * nloc) {
            __builtin_amdgcn_fence(__ATOMIC_RELEASE, "agent");
            asm volatile("s_waitcnt vmcnt(0)" ::: "memory");
            const unsigned og = xb_add(&bar[XB_TOP], 1u);
            const unsigned tg = og / nx;
            if (og + 1u == (tg + 1u) * nx) xb_add(&bar[XB_TOPGEN], 1u);
            else XB_SPIN(xb_ld(&bar[XB_TOPGEN]) == tg, bar);
            __builtin_amdgcn_fence(__ATOMIC_ACQUIRE, "agent");
            xb_add(&bar[XB_XGEN(b.x)], 1u);
            asm volatile("s_waitcnt vmcnt(0)" ::: "memory");
        } else {
            XB_SPIN(xb_ld(&bar[XB_XGEN(b.x)]) == gen, bar);
            __builtin_amdgcn_fence(__ATOMIC_ACQUIRE, "agent");
            asm volatile("s_waitcnt vmcnt(0)" ::: "memory");
        }
    }
    __syncthreads();
}
constexpr int NWAVES = 8;
constexpr int BATCH = 4, SEQ = 4096, DM = 2048, M = BATCH * SEQ;
constexpr int PLE = 256;
constexpr int GH = 4, GDK = 128, GDV = 256, GRANK = 16;
constexpr int SH = 8, SDH = 128;
constexpr int DIN_SRC = 7184;
constexpr int LDU = 7168;
constexpr int UQ = 0, UK = 512, UV = 1024, UG = 2048, USQ = 3072, USK = 4096, USV = 5120, USG = 6144;
constexpr float EPS = 1e-6f;
constexpr float SB_T = 30.0f;

constexpr size_t MiB = 1u << 20;
constexpr size_t WS_CTL = 0, CTL_ZERO_BYTES = 1 * MiB;
constexpr size_t WS_WIN = 2 * MiB, WS_WOUT = 30 * MiB, WS_WG = 38 * MiB, WS_WP = 46 * MiB;
constexpr size_t WS_RS = 47 * MiB, WS_GLR = 48 * MiB, WS_PIN = 50 * MiB;
constexpr size_t WS_XB = 64 * MiB;
constexpr size_t WS_U = 128 * MiB;
constexpr size_t WS_PB = 128 * MiB;
constexpr size_t WS_MIXIN = 352 * MiB;
constexpr size_t WS_END = 481 * MiB;
constexpr int CW_BAR = 4096;

constexpr int RING_OFF = 0, RING_BYTES = 131072;
constexpr int LDSCTL_OFF = RING_BYTES, MISC_OFF = LDSCTL_OFF + 320;
constexpr int LDS_BYTES = 147456;

struct Frame {
    LAS unsigned char* lds;
    volatile LAS unsigned* MISC;
    gu32* ctl;
    int vcu, G;
};
#define PHASE_IDS() int tid_o = threadIdx.x; asm volatile("" : "+v"(tid_o)); const int tid = tid_o, lane = tid & 63, wave = __builtin_amdgcn_readfirstlane(tid >> 6); (void)tid; (void)lane; (void)wave
__device__ __forceinline__ float wave_sum(float v) {
#pragma unroll
    for (int o = 1; o < 64; o <<= 1) v += __shfl_xor(v, o);
    return v;
}
__device__ __forceinline__ float bf_lo(unsigned w) { return __uint_as_float(w << 16); }
__device__ __forceinline__ float bf_hi(unsigned w) { return __uint_as_float(w & 0xffff0000u); }
__device__ __forceinline__ float bf2f(bf16 b) { return __uint_as_float(((unsigned)b) << 16); }

__device__ __forceinline__ void p0_transpose_item(const float* W, int ldw, int K, bf16* WT, int n_src0, int n_dst0, int k0, const float* gk, LAS float* scr, int lane) {
#pragma unroll 8
    for (int i = 0; i < 32; ++i) { const int kk = 2 * i + (lane >> 5); float v = W[(size_t)(k0 + kk) * ldw + n_src0 + (lane & 31)]; if (gk) v *= gk[k0 + kk]; scr[kk * 33 + (lane & 31)] = v; }
    LDS_WAIT(); asm volatile("" ::: "memory");
    const int c = lane & 7;
#pragma unroll
    for (int j = 0; j < 4; ++j) { const int n = (lane >> 3) + 8 * j; const LAS float* s = scr + (8 * c) * 33 + n;
        v4u o; o.x = pk2(s[0 * 33], s[1 * 33]); o.y = pk2(s[2 * 33], s[3 * 33]); o.z = pk2(s[4 * 33], s[5 * 33]); o.w = pk2(s[6 * 33], s[7 * 33]);
        *(GAS v4u*)(WT + (size_t)(n_dst0 + n) * K + k0 + 8 * c) = o; }
    LDS_WAIT(); asm volatile("" ::: "memory");
}

struct Args { const float* in[12]; float* out; unsigned char* ws; };

__device__ __forceinline__ void p0_prologue(Frame& F, const Args& A) {
    PHASE_IDS();
    const float* x = A.in[0]; const float* p = A.in[1]; const float* g_pre = A.in[2]; const float* w_in = A.in[3];
    const float* w_out = A.in[7]; const float* w_g = A.in[9]; const float* w_p = A.in[11];
    unsigned char* ws = A.ws;
    bf16* WinT = (bf16*)(ws + WS_WIN); bf16* WoutT = (bf16*)(ws + WS_WOUT); bf16* WgT = (bf16*)(ws + WS_WG); bf16* WpT = (bf16*)(ws + WS_WP);
    bf16* XB = (bf16*)(ws + WS_XB); bf16* PIN = (bf16*)(ws + WS_PIN); float* RS = (float*)(ws + WS_RS); float* GLR = (float*)(ws + WS_GLR);
    LAS float* scr = (LAS float*)(F.lds + RING_OFF + wave * 16384);
    const int gw = F.vcu * NWAVES + wave, NGW = F.G * NWAVES;
    constexpr int I_IN = (DM / 64) * (LDU / 32), I_SQ = (DM / 64) * (DM / 32), I_P = (PLE / 64) * (DM / 32);
    constexpr int NITEMS = I_IN + 2 * I_SQ + I_P;
    for (int it = gw; it < NITEMS; it += NGW) {
        int r = it;
        if (r < I_IN) { const int nblk = LDU / 32, kb = r / nblk, nb = r % nblk, nd = 32 * nb, ns = nd + (nd >= 3072 ? 16 : 0);
            p0_transpose_item(w_in, DIN_SRC, DM, WinT, ns, nd, 64 * kb, g_pre, scr, lane); continue; }
        r -= I_IN;
        if (r < I_SQ) { const int nblk = DM / 32, kb = r / nblk, nb = r % nblk; p0_transpose_item(w_out, DM, DM, WoutT, 32 * nb, 32 * nb, 64 * kb, nullptr, scr, lane); continue; }
        r -= I_SQ;
        if (r < I_SQ) { const int nblk = DM / 32, kb = r / nblk, nb = r % nblk; p0_transpose_item(w_g, DM, DM, WgT, 32 * nb, 32 * nb, 64 * kb, nullptr, scr, lane); continue; }
        r -= I_SQ;
        { const int nblk = DM / 32, kb = r / nblk, nb = r % nblk; p0_transpose_item(w_p, DM, PLE, WpT, 32 * nb, 32 * nb, 64 * kb, nullptr, scr, lane); }
    }
    for (int m = gw; m < M; m += NGW) {
        const f32x4 v = *((const GAS f32x4*)(p + (size_t)m * PLE) + lane);
        *((GAS unsigned long long*)(PIN + (size_t)m * PLE) + lane) = (unsigned long long)pk2(v.x, v.y) | ((unsigned long long)pk2(v.z, v.w) << 32);
    }
    for (int m = gw; m < M; m += NGW) {
        const GAS f32x4* xr = (const GAS f32x4*)(x + (size_t)m * DM) + lane;
        f32x4 v[8]; float ss = 0.f;
#pragma unroll
        for (int j = 0; j < 8; ++j) { v[j] = xr[64 * j]; ss += (v[j].x * v[j].x + v[j].y * v[j].y) + (v[j].z * v[j].z + v[j].w * v[j].w); }
        GAS unsigned long long* o8 = (GAS unsigned long long*)(XB + (size_t)m * DM) + lane;
#pragma unroll
        for (int j = 0; j < 8; ++j) o8[64 * j] = (unsigned long long)pk2(v[j].x, v[j].y) | ((unsigned long long)pk2(v[j].z, v[j].w) << 32);
        float acc[16];
#pragma unroll
        for (int n = 0; n < 16; ++n) acc[n] = 0.f;
#pragma unroll
        for (int j = 0; j < 8; ++j) {
            const int kbase = 256 * j + 4 * lane;
            const f32x4 gv = *(const GAS f32x4*)(g_pre + kbase);
#pragma unroll
            for (int i = 0; i < 4; ++i) {
                const float xs = v[j][i] * gv[i];
                const GAS f32x4* wr_ = (const GAS f32x4*)(w_in + (size_t)(kbase + i) * DIN_SRC + 3072);
#pragma unroll
                for (int q = 0; q < 4; ++q) { const f32x4 w4 = wr_[q]; acc[4 * q + 0] += xs * w4.x; acc[4 * q + 1] += xs * w4.y; acc[4 * q + 2] += xs * w4.z; acc[4 * q + 3] += xs * w4.w; }
            }
        }
        ss = wave_sum(ss);
        const float r = 1.0f / sqrtf(ss * (1.0f / DM) + EPS);
        float mine = 0.f;
#pragma unroll
        for (int n = 0; n < 16; ++n) { const float s = wave_sum(acc[n]); mine = (lane == n) ? s : mine; }
        if (lane < 16) GLR[(size_t)m * 16 + lane] = mine * r;
        if (lane == 0) RS[m] = r;
    }
}

__device__ __forceinline__ float log_sigmoidf(float x) { return fminf(x, 0.f) - log1pf(expf(-fabsf(x))); }
__device__ __forceinline__ void gla_naive(Frame& F, const Args& A, int bh) {
    PHASE_IDS();
    const float* w_a2 = A.in[4]; const float* b_a = A.in[5]; const float* g_head = A.in[6];
    const bf16* U = (const bf16*)(A.ws + WS_U); const float* GLR = (const float*)(A.ws + WS_GLR); bf16* MIXIN = (bf16*)(A.ws + WS_MIXIN);
    const int b = bh >> 2, h = bh & 3;
    constexpr int TB = 32;
    LAS float* qs = (LAS float*)(F.lds);
    LAS float* ks = qs + TB * 128;
    LAS float* as = ks + TB * 128;
    LAS float* os = as + TB * 128;
    float S[128];
#pragma unroll
    for (int d = 0; d < 128; ++d) S[d] = 0.f;
    const int dd = tid & 127, tq = tid >> 7;
    float wa[16];
#pragma unroll
    for (int i = 0; i < 16; ++i) wa[i] = w_a2[i * 512 + h * 128 + dd];
    const float ba = b_a[h * 128 + dd];
    for (int t0 = 0; t0 < SEQ; t0 += TB) {
        const size_t m0 = (size_t)b * SEQ + t0;
#pragma unroll
        for (int i = 0; i < 8; ++i) { const int idx = tid + 512 * i, t = idx >> 7, d = idx & 127;
            qs[idx] = bf2f(U[(m0 + t) * LDU + UQ + h * 128 + d]); ks[idx] = bf2f(U[(m0 + t) * LDU + UK + h * 128 + d]); }
#pragma unroll
        for (int tt = 0; tt < 8; ++tt) { const int t = tq * 8 + tt; float pre = ba;
#pragma unroll
            for (int i = 0; i < 16; ++i) pre += GLR[(m0 + t) * 16 + i] * wa[i];
            as[t * 128 + dd] = expf(log_sigmoidf(pre) * (1.0f / 16.0f)); }
        __syncthreads();
        if (tid < 256) {
            for (int t = 0; t < TB; ++t) {
                const float v = bf2f(U[(m0 + t) * LDU + UV + h * 256 + tid]);
                float o = 0.f;
#pragma unroll
                for (int d = 0; d < 128; d += 4) {
                    const f32x4 a4 = *(const LAS f32x4*)(as + t * 128 + d), k4 = *(const LAS f32x4*)(ks + t * 128 + d), q4 = *(const LAS f32x4*)(qs + t * 128 + d);
                    S[d + 0] = a4.x * S[d + 0] + k4.x * v; o += q4.x * S[d + 0];
                    S[d + 1] = a4.y * S[d + 1] + k4.y * v; o += q4.y * S[d + 1];
                    S[d + 2] = a4.z * S[d + 2] + k4.z * v; o += q4.z * S[d + 2];
                    S[d + 3] = a4.w * S[d + 3] + k4.w * v; o += q4.w * S[d + 3];
                }
                os[t * 256 + tid] = o * 0.08838834764831845f;
            }
        }
        __syncthreads();
#pragma unroll
        for (int rr = 0; rr < 4; ++rr) { const int t = wave * 4 + rr; float ov[4]; float ss = 0.f;
#pragma unroll
            for (int i = 0; i < 4; ++i) { ov[i] = os[t * 256 + lane + 64 * i]; ss += ov[i] * ov[i]; }
            ss = wave_sum(ss); const float r = 1.0f / sqrtf(ss * (1.0f / 256.0f) + EPS);
#pragma unroll
            for (int i = 0; i < 4; ++i) { const int e = lane + 64 * i; const float g = bf2f(U[(m0 + t) * LDU + UG + h * 256 + e]);
                const float val = ov[i] * r * g_head[e] * (g / (1.0f + expf(-g)));
                MIXIN[(m0 + t) * DM + h * 256 + e] = (bf16)f2bf(val); } }
        __syncthreads();
    }
}

__device__ __forceinline__ void sb_naive(Frame& F, const Args& A, int item) {
    PHASE_IDS();
    const bf16* U = (const bf16*)(A.ws + WS_U); bf16* MIXIN = (bf16*)(A.ws + WS_MIXIN);
    const int tg = item & 63, h = (item >> 6) & 7, b = item >> 9;
    const int t0 = tg * 64, t = t0 + lane; const size_t mrow = (size_t)b * SEQ + t;
    unsigned qp[64];
    { const GAS v4u* qsrc = (const GAS v4u*)(U + mrow * LDU + USQ + h * 128);
#pragma unroll
      for (int i = 0; i < 16; ++i) { const v4u w = qsrc[i]; qp[4 * i] = w.x; qp[4 * i + 1] = w.y; qp[4 * i + 2] = w.z; qp[4 * i + 3] = w.w; } }
    const float scale = 0.08838834764831845f;
    for (int half = 0; half < 2; ++half) {
        float o[64];
#pragma unroll
        for (int d = 0; d < 64; ++d) o[d] = 0.f;
        float R = 0.f;
        for (int j = t0 + 62; j >= 0; --j) {
            if (__ballot(R > -SB_T) == 0ull) break;
            const size_t krow = (size_t)b * SEQ + j;
            const unsigned kw = *(const GAS unsigned*)(U + krow * LDU + USK + h * 128 + 2 * lane);
            const unsigned vw = *(const GAS unsigned*)(U + krow * LDU + USV + h * 128 + 64 * half + 2 * (lane & 31));
            float z = 0.f;
#pragma unroll
            for (int i = 0; i < 64; ++i) { const unsigned kk = (unsigned)__builtin_amdgcn_readlane((int)kw, i); z += bf_lo(qp[i]) * bf_lo(kk); z += bf_hi(qp[i]) * bf_hi(kk); }
            z *= scale;
            const bool act = j < t;
            const float lk = -(fmaxf(z, 0.f) + log1pf(expf(-fabsf(z))));
            const float Rn = R + lk;
            const float w = act ? expf(z + Rn) : 0.f;
            R = act ? Rn : R;
#pragma unroll
            for (int i = 0; i < 32; ++i) { const unsigned vv = (unsigned)__builtin_amdgcn_readlane((int)vw, i); o[2 * i] += w * bf_lo(vv); o[2 * i + 1] += w * bf_hi(vv); }
        }
        const GAS v4u* gsrc = (const GAS v4u*)(U + mrow * LDU + USG + h * 128 + 64 * half);
        GAS v4u* dst = (GAS v4u*)(MIXIN + mrow * DM + 1024 + h * 128 + 64 * half);
#pragma unroll
        for (int i = 0; i < 8; ++i) { const v4u gw_ = gsrc[i]; const unsigned gws[4] = {gw_.x, gw_.y, gw_.z, gw_.w}; unsigned ow[4];
#pragma unroll
            for (int q = 0; q < 4; ++q) { const float g0 = bf_lo(gws[q]), g1 = bf_hi(gws[q]);
                const float v0 = o[8 * i + 2 * q] * (g0 / (1.0f + expf(-g0))), v1 = o[8 * i + 2 * q + 1] * (g1 / (1.0f + expf(-g1)));
                ow[q] = pk2(v0, v1); }
            v4u w; w.x = ow[0]; w.y = ow[1]; w.z = ow[2]; w.w = ow[3]; dst[i] = w; }
    }
}

__device__ __forceinline__ void p5_postnorm(Frame& F, const Args& A) {
    PHASE_IDS();
    const float* x = A.in[0]; const float* g_post = A.in[8]; float* out = A.out; bf16* HB = (bf16*)(A.ws + WS_XB);
    const int gw = F.vcu * NWAVES + wave, NGW = F.G * NWAVES;
    for (int m = gw; m < M; m += NGW) {
        GAS f32x4* mr = (GAS f32x4*)(out + (size_t)m * DM) + lane; const GAS f32x4* xr = (const GAS f32x4*)(x + (size_t)m * DM) + lane;
        f32x4 v[8]; float ss = 0.f;
#pragma unroll
        for (int j = 0; j < 8; ++j) { v[j] = mr[64 * j]; ss += (v[j].x * v[j].x + v[j].y * v[j].y) + (v[j].z * v[j].z + v[j].w * v[j].w); }
        ss = wave_sum(ss); const float r = 1.0f / sqrtf(ss * (1.0f / DM) + EPS);
        GAS unsigned long long* o8 = (GAS unsigned long long*)(HB + (size_t)m * DM) + lane;
#pragma unroll
        for (int j = 0; j < 8; ++j) { const f32x4 gv = *((const GAS f32x4*)g_post + lane + 64 * j); const f32x4 xv = xr[64 * j];
            f32x4 hv; hv.x = xv.x + v[j].x * r * gv.x; hv.y = xv.y + v[j].y * r * gv.y; hv.z = xv.z + v[j].z * r * gv.z; hv.w = xv.w + v[j].w * r * gv.w;
            mr[64 * j] = hv; o8[64 * j] = (unsigned long long)pk2(hv.x, hv.y) | ((unsigned long long)pk2(hv.z, hv.w) << 32); }
    }
}

__global__ void __launch_bounds__(NWAVES * 64, 2) fwd_megakernel(Args args) {
    extern __shared__ __attribute__((aligned(16))) unsigned char lds[];
    Frame F;
    F.lds = (LAS unsigned char*)lds;
    F.MISC = (volatile LAS unsigned*)(F.lds + MISC_OFF);
    F.G = gridDim.x; { const int bx = blockIdx.x; F.vcu = (F.G % 8 == 0) ? (bx % 8) * (F.G / 8) + bx / 8 : bx; }
    unsigned char* ws = args.ws;
    F.ctl = (gu32*)(ws + WS_CTL);
    for (int u = threadIdx.x; u < (LDS_BYTES - LDSCTL_OFF) / 4; u += NWAVES * 64) ((LAS unsigned*)(F.lds + LDSCTL_OFF))[u] = 0u;
    __syncthreads();
    XcdBarrier bar = xcd_barrier_post((unsigned*)(F.ctl + CW_BAR), F.MISC + 8);

    bf16* WinT = (bf16*)(ws + WS_WIN); bf16* WoutT = (bf16*)(ws + WS_WOUT); bf16* WgT = (bf16*)(ws + WS_WG); bf16* WpT = (bf16*)(ws + WS_WP);
    bf16* XB = (bf16*)(ws + WS_XB); bf16* PIN = (bf16*)(ws + WS_PIN); float* RS = (float*)(ws + WS_RS);
    bf16* U = (bf16*)(ws + WS_U); bf16* PB = (bf16*)(ws + WS_PB); bf16* MIXIN = (bf16*)(ws + WS_MIXIN);

#ifndef NO_P0
    p0_prologue(F, args);
#endif
    xcd_barrier(bar);
#ifndef NO_G1
    { pg8::Gemm g{XB, WinT, M, LDU, DM}; pg8::StaticOrder S; S.init(M, LDU, F.G, (int)blockIdx.x);
      pg8::EpiU E{U, LDU, RS};
      pg8::gemm_phase<pg8::EpiU, pg8::StaticOrder, true, true>(F.lds + RING_OFF, g, S, E); }
#endif
    xcd_barrier(bar);
    {
#ifndef NO_GLA
      if ((int)blockIdx.x < 16) gla_naive(F, args, (int)blockIdx.x);
#endif
      const int gw = (int)blockIdx.x * NWAVES + (int)__builtin_amdgcn_readfirstlane(threadIdx.x >> 6), NGW = F.G * NWAVES;
#ifndef NO_SB
      for (int it = gw; it < BATCH * SH * 64; it += NGW) sb_naive(F, args, it);
#endif
    }
    xcd_barrier(bar);
#ifndef NO_G2
    { pg8::Gemm g{MIXIN, WoutT, M, DM, DM}; pg8::StaticOrder S; S.init(M, DM, F.G, (int)blockIdx.x);
      pg8::EpiF32 E{args.out, DM};
      pg8::gemm_phase<pg8::EpiF32, pg8::StaticOrder, true, true>(F.lds + RING_OFF, g, S, E); }
#endif
#ifndef NO_G4
    { pg8::Gemm g{PIN, WpT, M, DM, PLE}; pg8::StaticOrder S; S.init(M, DM, F.G, (int)blockIdx.x);
      pg8::EpiBf16<0> E{PB, DM, nullptr, 0, 0, 1.f};
      pg8::gemm_phase<pg8::EpiBf16<0>, pg8::StaticOrder, true, true>(F.lds + RING_OFF, g, S, E); }
#endif
    xcd_barrier(bar);
#ifndef NO_P5
    p5_postnorm(F, args);
#endif
    xcd_barrier(bar);
#ifndef NO_G3
    { pg8::Gemm g{XB, WgT, M, DM, DM}; pg8::StaticOrder S; S.init(M, DM, F.G, (int)blockIdx.x);
      pg8::EpiFinal E{args.out, PB, args.in[10], DM};
      pg8::gemm_phase<pg8::EpiFinal, pg8::StaticOrder, true, true>(F.lds + RING_OFF, g, S, E); }
#endif
}

extern "C" void kernel_launch(void* const* d_in, const int* in_sizes, int n_in, void* d_out, int out_size, void* d_ws, size_t ws_size, hipStream_t stream) {
    static int grid = 0;
    if (grid == 0) {
        if (n_in != 12 || in_sizes[0] != M * DM || out_size != M * DM || ws_size < WS_END) { fprintf(stderr, "kernel_launch: unexpected shapes: n_in %d in0 %d out %d ws %zu (need %zu)\n", n_in, n_in > 0 ? in_sizes[0] : -1, out_size, ws_size, (size_t)WS_END); grid = -1; return; }
        int dev = 0, cus = 0, per_cu = 0;
        if (hipGetDevice(&dev) != hipSuccess || hipDeviceGetAttribute(&cus, hipDeviceAttributeMultiprocessorCount, dev) != hipSuccess) { grid = -1; return; }
        if (hipFuncSetAttribute((const void*)fwd_megakernel, hipFuncAttributeMaxDynamicSharedMemorySize, LDS_BYTES) != hipSuccess) { fprintf(stderr, "kernel_launch: hipFuncSetAttribute failed\n"); grid = -1; return; }
        if (hipOccupancyMaxActiveBlocksPerMultiprocessor(&per_cu, (const void*)fwd_megakernel, NWAVES * 64, LDS_BYTES) != hipSuccess || per_cu < 1)
            fprintf(stderr, "kernel_launch: note: occupancy query reports %d workgroups per CU\n", per_cu);
        (void)hipGetLastError();
        grid = cus;
    }
    if (grid < 0) return;
    if (hipMemsetAsync((char*)d_ws + WS_CTL, 0, CTL_ZERO_BYTES, stream) != hipSuccess) { fprintf(stderr, "kernel_launch: hipMemsetAsync failed\n"); return; }
    Args a{};
    for (int i = 0; i < 12; ++i) a.in[i] = (const float*)d_in[i];
    a.out = (float*)d_out; a.ws = (unsigned char*)d_ws;
    hipLaunchKernelGGL(fwd_megakernel, dim3(grid), dim3(NWAVES * 64), LDS_BYTES, stream, a);
    const hipError_t le = hipPeekAtLastError();
    if (le != hipSuccess) fprintf(stderr, "kernel_launch: launch failed: %s\n", hipGetErrorName(le));
}
```

```cpp
#include <hip/hip_runtime.h>
#include <cstdio>
#include <cstdint>
namespace pg8 {
#define PG8_LAS __attribute__((address_space(3)))
typedef unsigned short bf16_t;
typedef short bf16x8 __attribute__((ext_vector_type(8)));
typedef float f32x4 __attribute__((ext_vector_type(4)));
typedef unsigned u32x4 __attribute__((ext_vector_type(4)));
constexpr int BM = 256, BK = 64, HALF = 128, HTB = HALF * BK * 2  , STAGE_BYTES = 8 * HTB, NXCD = 8, WGM = 8;

__host__ __device__ __forceinline__ int lds_byte(int r, int c) { const int st = (r >> 4) * 2 + (c >> 5), rr = r & 15, cc = c & 31, ob = rr * 64 + cc * 2; return st * 1024 + (ob ^ (((ob >> 9) & 1) << 5)); }
__host__ __device__ __forceinline__ void stage_rc(int b, int& R, int& C) { const int st = b / 1024, sb = b % 1024, swz = sb ^ (((sb >> 9) & 1) << 5); R = (st >> 1) * 16 + swz / 64; C = (st & 1) * 32 + (swz % 64) / 2; }
__host__ __device__ __forceinline__ int perm32(int rho) { const int n = rho >> 4, i = rho & 15; return 8 * (i >> 2) + 4 * n + (i & 3); }

struct Unit { int pm, pn; };
struct Gemm { const bf16_t* A; const bf16_t* Bt; int M, N, K; };

struct StaticOrder {
    int nM, nN, nwg, G, c;
    __host__ __device__ void init(int M, int N, int G_, int c_) { nM = M / BM; nN = N / BM; nwg = nM * nN; G = G_; c = c_; }
    __host__ __device__ bool next(int i, Unit& u) const {
        const long L = (long)i * G + c; if (L >= nwg) return false;
        int wgid = (int)L; { const int q = nwg / NXCD, r = nwg % NXCD, xcd = wgid % NXCD, off = wgid / NXCD; wgid = (xcd < r ? xcd * (q + 1) : r * (q + 1) + (xcd - r) * q) + off; }
        const int nig = WGM * nN, gid = wgid / nig, fm = gid * WGM, gsz = (nM - fm) < WGM ? (nM - fm) : WGM;
        u.pm = fm + ((wgid % nig) % gsz); u.pn = (wgid % nig) / gsz; return true;
    }
    __device__ __forceinline__ void a_ready(const Unit&) const {}
    __device__ __forceinline__ void done(const Unit&) const {}
};

__device__ __forceinline__ unsigned cvt_pk_bf16(float lo, float hi) { unsigned r; asm volatile("v_cvt_pk_bf16_f32 %0, %1, %2" : "=v"(r) : "v"(lo), "v"(hi)); return r; }
typedef float f32x2 __attribute__((ext_vector_type(2)));
__device__ __forceinline__ f32x2 gelu_pk(f32x2 v) {
    const f32x2 av = __builtin_elementwise_abs(v), d = av * 0.2316418882f + 1.0f;
    f32x2 t; t.x = __builtin_amdgcn_rcpf(d.x); t.y = __builtin_amdgcn_rcpf(d.y);
    f32x2 q = t * 0.5307027145f + (-0.7265760135f); q = q * t + 0.7107068705f; q = q * t + (-0.142248368f); q = q * t + 0.127414796f; q = q * t;
    const f32x2 s = (v * v) * (-0.72134752044f);
    f32x2 e; e.x = __builtin_amdgcn_exp2f(s.x); e.y = __builtin_amdgcn_exp2f(s.y);
    const f32x2 m = v * (q * e), r = v - m;
    f32x2 o; o.x = v.x < 0.f ? m.x : r.x; o.y = v.y < 0.f ? m.y : r.y; return o;
}

template <int ACT  > struct EpiBf16 {
    static constexpr bool PERM = true, AFTER_DRAIN = false; static_assert(ACT == 0 || ACT == 1, "EpiBf16: ACT is 0 (none) or 1 (gelu_pk)");
    bf16_t* O; int ldc; const float* bias; int split_cols; size_t split_stride; float scale0;
    __device__ __forceinline__ void operator()(const f32x4 (&acc)[2][2][4][2], const Unit& u, int wr, int wc, int fr, int fq) const {
        const int row0 = u.pm * BM + wr * 64 + fr; int colt = u.pn * BM; bf16_t* base = O;
        float sc = 1.f; if (split_cols) { const int t = colt / split_cols; base += (size_t)t * split_stride; colt -= t * split_cols; if (t == 0) sc = scale0; }
        const int col0 = colt + wc * 32 + 8 * fq, bcol0 = u.pn * BM + wc * 32 + 8 * fq;
        f32x4 bv[2][2];
#pragma unroll
        for (int bj = 0; bj < 2; ++bj)
#pragma unroll
            for (int n = 0; n < 2; ++n) bv[bj][n] = bias ? *(const f32x4*)(bias + bcol0 + bj * HALF + 4 * n) : (f32x4){0.f, 0.f, 0.f, 0.f};
#pragma unroll
        for (int ai = 0; ai < 2; ++ai)
#pragma unroll
            for (int m = 0; m < 4; ++m) { bf16_t* rowp = base + (size_t)(row0 + ai * HALF + m * 16) * ldc + col0;
#pragma unroll
                for (int bj = 0; bj < 2; ++bj) { f32x4 v0 = acc[ai][bj][m][0] + bv[bj][0], v1 = acc[ai][bj][m][1] + bv[bj][1];
                    if (ACT == 1) { f32x2 a = gelu_pk((f32x2){v0[0], v0[1]}), b = gelu_pk((f32x2){v0[2], v0[3]}), c = gelu_pk((f32x2){v1[0], v1[1]}), d = gelu_pk((f32x2){v1[2], v1[3]});
                        v0 = (f32x4){a.x, a.y, b.x, b.y}; v1 = (f32x4){c.x, c.y, d.x, d.y}; }
                    v0 = v0 * sc; v1 = v1 * sc; u32x4 w; w.x = cvt_pk_bf16(v0[0], v0[1]); w.y = cvt_pk_bf16(v0[2], v0[3]); w.z = cvt_pk_bf16(v1[0], v1[1]); w.w = cvt_pk_bf16(v1[2], v1[3]);
                    *(u32x4*)(rowp + bj * HALF) = w; } }
    }
};
__device__ __forceinline__ int epi_col0(const Unit& u, int wc, int fq) { return u.pm * 0 + u.pn * BM + 64 * wc + 16 * fq; }
struct EpiB16 {
    static constexpr bool PERM = true, AFTER_DRAIN = false;
    bf16_t* O; int ldc; const float* rs;
    __device__ __forceinline__ void operator()(const f32x4 (&acc)[2][2][4][2], const Unit& u, int wr, int wc, int fr, int fq) const {
        const int row0 = u.pm * BM + wr * 64 + fr; const int col0 = epi_col0(u, wc, fq);
#pragma unroll
        for (int ai = 0; ai < 2; ++ai)
#pragma unroll
            for (int m = 0; m < 4; ++m) { const int row = row0 + ai * HALF + m * 16; const float sc = rs ? rs[row] : 1.0f; bf16_t* rowp = O + (size_t)row * ldc + col0;
#pragma unroll
                for (int bj = 0; bj < 2; ++bj) { const f32x4 v0 = acc[ai][bj][m][0] * sc, v1 = acc[ai][bj][m][1] * sc;
                    u32x4 w; w.x = cvt_pk_bf16(v0[0], v0[1]); w.y = cvt_pk_bf16(v0[2], v0[3]); w.z = cvt_pk_bf16(v1[0], v1[1]); w.w = cvt_pk_bf16(v1[2], v1[3]);
                    *(u32x4*)(rowp + 8 * bj) = w; } }
    }
};
struct EpiFinal {
    static constexpr bool PERM = true, AFTER_DRAIN = false;
    const bf16_t* H; float* O; const bf16_t* P; const float* bg; int ldc;
    __device__ __forceinline__ void operator()(const f32x4 (&acc)[2][2][4][2], const Unit& u, int wr, int wc, int fr, int fq) const {
        const int row0 = u.pm * BM + wr * 64 + fr, col0 = epi_col0(u, wc, fq);
        f32x4 bv[2][2];
#pragma unroll
        for (int bj = 0; bj < 2; ++bj)
#pragma unroll
            for (int n = 0; n < 2; ++n) bv[bj][n] = *(const f32x4*)(bg + col0 + 8 * bj + 4 * n);
#pragma unroll
        for (int ai = 0; ai < 2; ++ai)
#pragma unroll
            for (int m = 0; m < 4; ++m) { const size_t off = (size_t)(row0 + ai * HALF + m * 16) * ldc + col0;
#pragma unroll
                for (int bj = 0; bj < 2; ++bj) { const size_t o2 = off + 8 * bj;
                    const u32x4 hw = *(const u32x4*)(H + o2), pw = *(const u32x4*)(P + o2);
                    const unsigned hws[4] = {hw.x, hw.y, hw.z, hw.w}, pws[4] = {pw.x, pw.y, pw.z, pw.w};
#pragma unroll
                    for (int n = 0; n < 2; ++n) { const f32x4 a = acc[ai][bj][m][n] + bv[bj][n]; f32x4 o;
                        o[0] = __uint_as_float(hws[2 * n] << 16) + __uint_as_float(pws[2 * n] << 16) / (1.0f + __expf(-a[0]));
                        o[1] = __uint_as_float(hws[2 * n] & 0xffff0000u) + __uint_as_float(pws[2 * n] & 0xffff0000u) / (1.0f + __expf(-a[1]));
                        o[2] = __uint_as_float(hws[2 * n + 1] << 16) + __uint_as_float(pws[2 * n + 1] << 16) / (1.0f + __expf(-a[2]));
                        o[3] = __uint_as_float(hws[2 * n + 1] & 0xffff0000u) + __uint_as_float(pws[2 * n + 1] & 0xffff0000u) / (1.0f + __expf(-a[3]));
                        *(f32x4*)(O + o2 + 4 * n) = o; } }
                if (m & 1) asm volatile("" ::: "memory"); }
    }
};
template <class Epi, class Sched, bool ALIGN_EPI = false, bool SP2 = false>
__device__ __forceinline__ void gemm_phase(PG8_LAS unsigned char* lds, const Gemm g, const Sched& S, const Epi& E, const int wave_in  ) {
    int lane_; asm volatile("v_mbcnt_lo_u32_b32 %0, -1, 0\n\tv_mbcnt_hi_u32_b32 %0, -1, %0" : "=v"(lane_));
    const int wid = wave_in, lane = lane_, tid = wid * 64 + lane, wr = wid >> 2, wc = wid & 3, fr = lane & 15, fq = lane >> 4;
    const int K = g.K, nt = K / BK;
    unsigned voffA[2], voffB[2];
#pragma unroll
    for (int i = 0; i < 2; ++i) { int R, C; stage_rc(tid * 16 + i * 8192, R, C); const int Rb = Epi::PERM ? ((R & ~31) + perm32(R & 31)) : R;
        voffA[i] = (unsigned)(R * K + C) * 2u; voffB[i] = (unsigned)(Rb * K + C) * 2u; }
    const size_t kstep = (size_t)(BK * 2);
    const size_t hstep = (size_t)HALF * K * 2;
    const size_t tstep = 2 * hstep;
    const unsigned ldsw = (unsigned)wid * 1024u;
    const int aoff = lds_byte(wr * 64 + fr, fq * 8), boff = lds_byte(wc * 32 + fr, fq * 8);
#define PG8_SA(b, h) (((b) * 2 + (h)) * HTB)
#define PG8_SB(b, h) ((4 + (b) * 2 + (h)) * HTB)
#define PG8_STAGE(bufoff, gbase, voff) do { _Pragma("unroll") for (int _i = 0; _i < 2; ++_i) \
        __builtin_amdgcn_global_load_lds((const unsigned*)((const char*)(gbase) + (voff)[_i]), (PG8_LAS unsigned*)(lds + (bufoff) + ldsw + _i * 8192), 16, 0, 0); } while (0)
#define PG8_LDA(dst, b, h) do { _Pragma("unroll") for (int m = 0; m < 4; ++m) _Pragma("unroll") for (int k = 0; k < 2; ++k) dst[m][k] = *(const PG8_LAS bf16x8*)(lds + PG8_SA(b, h) + aoff + m * 2048 + k * 1024); } while (0)
#define PG8_LDB(dst, b, h) do { _Pragma("unroll") for (int n = 0; n < 2; ++n) _Pragma("unroll") for (int k = 0; k < 2; ++k) dst[n][k] = *(const PG8_LAS bf16x8*)(lds + PG8_SB(b, h) + boff + n * 2048 + k * 1024); } while (0)
#define PG8_MMA(ai, bj, At, Bt) do { __builtin_amdgcn_s_setprio(1); _Pragma("unroll") for (int m = 0; m < 4; ++m) _Pragma("unroll") for (int n = 0; n < 2; ++n) _Pragma("unroll") for (int k = 0; k < 2; ++k) \
        acc[ai][bj][m][n] = __builtin_amdgcn_mfma_f32_16x16x32_bf16(Bt[n][k], At[m][k], acc[ai][bj][m][n], 0, 0, 0); __builtin_amdgcn_s_setprio(0); } while (0)
#define PG8_WAIT_V(n) asm volatile("s_waitcnt vmcnt(" #n ")" ::: "memory")
#define PG8_WAIT_L(n) asm volatile("s_waitcnt lgkmcnt(" #n ")" ::: "memory")
#define PG8_BAR __builtin_amdgcn_s_barrier()
#define PG8_SCHED __builtin_amdgcn_sched_barrier(0)
    Unit cur, nxt; int ui = 0;
    if (!S.next(0, cur)) return;
    f32x4 acc[2][2][4][2];
#pragma unroll
    for (int a = 0; a < 2; ++a)
#pragma unroll
        for (int b = 0; b < 2; ++b)
#pragma unroll
            for (int m = 0; m < 4; ++m)
#pragma unroll
                for (int n = 0; n < 2; ++n) acc[a][b][m][n] = (f32x4){0.f, 0.f, 0.f, 0.f};
    bf16x8 At[4][2], B0[2][2], B1[2][2];
    const char* cA = (const char*)g.A + (size_t)cur.pm * tstep; const char* cB = (const char*)g.Bt + (size_t)cur.pn * tstep;
    S.a_ready(cur);
    if constexpr (SP2) {
        PG8_STAGE(PG8_SB(0, 0), cB, voffB); PG8_STAGE(PG8_SB(0, 1), cB + hstep, voffB); PG8_STAGE(PG8_SA(0, 0), cA, voffA); PG8_STAGE(PG8_SA(0, 1), cA + hstep, voffA);
        if (wr == 1) PG8_BAR;
        PG8_WAIT_V(2); PG8_BAR;
        PG8_STAGE(PG8_SB(1, 0), cB + kstep, voffB); PG8_STAGE(PG8_SA(1, 0), cA + kstep, voffA); PG8_STAGE(PG8_SB(1, 1), cB + hstep + kstep, voffB);
        PG8_WAIT_V(6); PG8_BAR;
    } else {
        PG8_STAGE(PG8_SB(0, 0), cB, voffB); PG8_STAGE(PG8_SA(0, 0), cA, voffA); PG8_STAGE(PG8_SB(0, 1), cB + hstep, voffB); PG8_STAGE(PG8_SA(0, 1), cA + hstep, voffA);
        if (wr == 1) PG8_BAR;
        PG8_WAIT_V(4); PG8_BAR;
        PG8_STAGE(PG8_SB(1, 0), cB + kstep, voffB); PG8_STAGE(PG8_SA(1, 0), cA + kstep, voffA); PG8_STAGE(PG8_SB(1, 1), cB + hstep + kstep, voffB);
        PG8_WAIT_V(6); PG8_BAR;
    }
    for (;;) {
        const bool has_next = S.next(ui + 1, nxt);
        const char* nA = has_next ? (const char*)g.A + (size_t)nxt.pm * tstep : cA; const char* nB = has_next ? (const char*)g.Bt + (size_t)nxt.pn * tstep : cB;
        for (int t = 0; t < nt; t += 2) {
            const bool last = (t == nt - 2);
            const char* a1 = cA + (size_t)(t + 1) * kstep;
            const char* a2 = last ? nA : cA + (size_t)(t + 2) * kstep; const char* b2 = last ? nB : cB + (size_t)(t + 2) * kstep;
            const char* a3 = a2 + kstep; const char* b3 = b2 + kstep;
            if (last && has_next) S.a_ready(nxt);
            if constexpr (SP2) {
            PG8_LDB(B0, 0, 0); PG8_LDB(B1, 0, 1); PG8_SCHED; PG8_LDA(At, 0, 0); PG8_STAGE(PG8_SA(1, 1), a1 + hstep, voffA);
            PG8_WAIT_V(8); PG8_WAIT_L(0); PG8_BAR; PG8_MMA(0, 0, At, B0); PG8_MMA(0, 1, At, B1); PG8_BAR; PG8_SCHED;
            PG8_LDA(At, 0, 1); PG8_STAGE(PG8_SB(0, 0), b2, voffB); PG8_STAGE(PG8_SB(0, 1), b2 + hstep, voffB); PG8_STAGE(PG8_SA(0, 0), a2, voffA);
            PG8_WAIT_V(8); PG8_WAIT_L(0); PG8_BAR; PG8_MMA(1, 0, At, B0); PG8_MMA(1, 1, At, B1); PG8_BAR; PG8_SCHED;
            PG8_LDB(B0, 1, 0); PG8_LDB(B1, 1, 1); PG8_SCHED; PG8_LDA(At, 1, 0); PG8_STAGE(PG8_SA(0, 1), a2 + hstep, voffA);
            PG8_WAIT_V(8); PG8_WAIT_L(0); PG8_BAR; PG8_MMA(0, 0, At, B0); PG8_MMA(0, 1, At, B1); PG8_BAR; PG8_SCHED;
            PG8_LDA(At, 1, 1); PG8_STAGE(PG8_SB(1, 0), b3, voffB); PG8_STAGE(PG8_SB(1, 1), b3 + hstep, voffB); PG8_STAGE(PG8_SA(1, 0), a3, voffA);
            PG8_WAIT_V(8); PG8_WAIT_L(0); PG8_BAR; PG8_MMA(1, 0, At, B0); PG8_MMA(1, 1, At, B1); PG8_BAR; PG8_SCHED;
            } else {
            PG8_LDB(B0, 0, 0); PG8_SCHED; PG8_LDA(At, 0, 0); PG8_STAGE(PG8_SA(1, 1), a1 + hstep, voffA);
            PG8_WAIT_L(8); PG8_BAR; PG8_WAIT_L(0); PG8_MMA(0, 0, At, B0); PG8_BAR; PG8_SCHED;
            PG8_LDB(B1, 0, 1); PG8_STAGE(PG8_SB(0, 0), b2, voffB);
            PG8_BAR; PG8_WAIT_L(0); PG8_MMA(0, 1, At, B1); PG8_BAR;
            PG8_LDA(At, 0, 1); PG8_STAGE(PG8_SA(0, 0), a2, voffA);
            PG8_BAR; PG8_WAIT_L(0); PG8_MMA(1, 0, At, B0); PG8_BAR; PG8_SCHED;
            PG8_STAGE(PG8_SB(0, 1), b2 + hstep, voffB);
            PG8_WAIT_V(6); PG8_BAR; PG8_MMA(1, 1, At, B1); PG8_BAR;
            PG8_LDB(B0, 1, 0); PG8_SCHED; PG8_LDA(At, 1, 0); PG8_STAGE(PG8_SA(0, 1), a2 + hstep, voffA);
            PG8_WAIT_L(8); PG8_BAR; PG8_WAIT_L(0); PG8_MMA(0, 0, At, B0); PG8_BAR; PG8_SCHED;
            PG8_LDB(B1, 1, 1); PG8_STAGE(PG8_SB(1, 0), b3, voffB);
            PG8_BAR; PG8_WAIT_L(0); PG8_MMA(0, 1, At, B1); PG8_BAR;
            PG8_LDA(At, 1, 1); PG8_STAGE(PG8_SA(1, 0), a3, voffA);
            PG8_BAR; PG8_WAIT_L(0); PG8_MMA(1, 0, At, B0); PG8_BAR; PG8_SCHED;
            PG8_STAGE(PG8_SB(1, 1), b3 + hstep, voffB);
            PG8_WAIT_V(6); PG8_BAR; PG8_MMA(1, 1, At, B1); PG8_BAR;
            }
        }
        if constexpr (ALIGN_EPI) { if (wr == 0) PG8_BAR; }
        if constexpr (!Epi::AFTER_DRAIN) { E(acc, cur, wr, wc, fr, fq); S.done(cur); }
        if (!has_next) break;
#pragma unroll
        for (int a = 0; a < 2; ++a)
#pragma unroll
            for (int b = 0; b < 2; ++b)
#pragma unroll
                for (int m = 0; m < 4; ++m)
#pragma unroll
                    for (int n = 0; n < 2; ++n) acc[a][b][m][n] = (f32x4){0.f, 0.f, 0.f, 0.f};
        cur = nxt; cA = nA; cB = nB; ++ui;
        if constexpr (ALIGN_EPI) { if (wr == 1) PG8_BAR; }
    }
    PG8_WAIT_V(0);
    if constexpr (!ALIGN_EPI) { if (wr == 0) PG8_BAR; }
    PG8_BAR;
    if constexpr (Epi::AFTER_DRAIN) { E.fused(acc, cur, wr, wc, fr, fq, lds, wid, lane); S.done(cur); }
#undef PG8_SA
#undef PG8_SB
#undef PG8_STAGE
#undef PG8_LDA
#undef PG8_LDB
#undef PG8_MMA
#undef PG8_WAIT_V
#undef PG8_WAIT_L
#undef PG8_BAR
#undef PG8_SCHED
}
}
#define GAS __attribute__((address_space(1)))
#define LAS __attribute__((address_space(3)))
typedef unsigned short bf16;
typedef unsigned v4u __attribute__((ext_vector_type(4)));
typedef float f32x4 __attribute__((ext_vector_type(4)));
typedef short bf16x8 __attribute__((ext_vector_type(8)));
typedef GAS unsigned gu32;
typedef GAS unsigned long long gu64;
#define RLX_AGENT __ATOMIC_RELAXED, __HIP_MEMORY_SCOPE_AGENT
#define LDS_WAIT() asm volatile("s_waitcnt lgkmcnt(0)" ::: "memory")
#define VM_WAIT() asm volatile("s_waitcnt vmcnt(0)" ::: "memory")
__device__ __forceinline__ unsigned long long rt() { return __builtin_amdgcn_s_memrealtime(); }
__device__ __forceinline__ unsigned f2bf(float f) { unsigned u = __builtin_bit_cast(unsigned, f); return (u + 0x7fffu + ((u >> 16) & 1u)) >> 16; }
__device__ __forceinline__ unsigned pk2(float lo, float hi) { return f2bf(lo) | (f2bf(hi) << 16); }

#define XB_TMO      128
#define XB_XCNT(j)  (256  + 64 * (j))
#define XB_XSUB(j)  (1280 + 64 * (j))
#define XB_XGEN(j)  (2304 + 64 * (j))
#define XB_TOP      3328
#define XB_TOPGEN   3392
#define XCD_BAR_WORDS 3456
#define XB_SPIN_CAP (1u << 18)

__device__ __forceinline__ unsigned xb_ld(unsigned* p)              { return __hip_atomic_load(p, __ATOMIC_RELAXED, __HIP_MEMORY_SCOPE_AGENT); }
__device__ __forceinline__ unsigned xb_add(unsigned* p, unsigned v) { return __hip_atomic_fetch_add(p, v, __ATOMIC_RELAXED, __HIP_MEMORY_SCOPE_AGENT); }
__device__ __forceinline__ unsigned xb_xcc_id() { return (unsigned)__builtin_amdgcn_s_getreg((3 << 11) | 20) & 0xFu; }
#define XB_SPIN(cond, bar) do { unsigned _sp = 0; while (cond) { __builtin_amdgcn_s_sleep(1); \
    if ((++_sp & 255u) == 0u) { if (xb_ld(&(bar)[XB_TMO])) break; if (_sp > XB_SPIN_CAP) { atomicAdd(&(bar)[XB_TMO], 1u); break; } } } } while (0)

struct XcdBarrier {
    unsigned* bar; unsigned x; unsigned w;
    volatile LAS unsigned* st;
};

__device__ __forceinline__ XcdBarrier xcd_barrier_post(unsigned* bar, volatile LAS unsigned* st) {
    XcdBarrier b; b.bar = bar; b.x = xb_xcc_id(); b.st = st; b.w = (unsigned)__builtin_amdgcn_readfirstlane(threadIdx.x >> 6);
    if (threadIdx.x == 0) (void)xb_add(&bar[XB_XCNT(b.x)], 1u);
    return b;
}
__device__ __forceinline__ void xcd_barrier_complete(unsigned* bar, unsigned x, unsigned& nloc, unsigned& nx) {
    const unsigned G = gridDim.x * gridDim.y * gridDim.z;
    unsigned sum, cnt, mine, sp = 0u;
    for (;;) {
        sum = 0u; cnt = 0u; mine = 0u;
#pragma unroll
        for (unsigned j = 0; j < 16; ++j) { const unsigned c = xb_ld(&bar[XB_XCNT(j)]); sum += c; cnt += (c > 0u) ? 1u : 0u; mine = (j == x) ? c : mine; }
        if (sum == G) break;
        __builtin_amdgcn_s_sleep(1);
        if ((++sp & 255u) == 0u) { if (xb_ld(&bar[XB_TMO])) break; if (sp > XB_SPIN_CAP) { atomicAdd(&bar[XB_TMO], 1u); break; } }
    }
    nloc = mine > 0u ? mine : 1u; nx = cnt > 0u ? cnt : 1u;
}

__device__ __forceinline__ void xcd_barrier(const XcdBarrier& b) {
    asm volatile("s_waitcnt vmcnt(0)" ::: "memory");
    __syncthreads();
    unsigned lane_b; asm volatile("v_mbcnt_lo_u32_b32 %0, -1, 0\n\tv_mbcnt_hi_u32_b32 %0, -1, %0" : "=v"(lane_b));
    if (b.w == 0u && lane_b == 0u) {
        unsigned* bar = b.bar;
        __builtin_amdgcn_s_waitcnt(0);
        unsigned nloc = b.st[0], nx = b.st[1];
        if (nloc == 0u) { xcd_barrier_complete(bar, b.x, nloc, nx); b.st[0] = nloc; b.st[1] = nx; }
        const unsigned old = xb_add(&bar[XB_XSUB(b.x)], 1u);
        const unsigned gen = old / nloc;
        if (old + 1u == (gen + 1u) * nloc) {
            __builtin_amdgcn_fence(__ATOMIC_RELEASE, "agent");
            asm volatile("s_waitcnt vmcnt(0)" ::: "memory");
            const unsigned og = xb_add(&bar[XB_TOP], 1u);
            const unsigned tg = og / nx;
            if (og + 1u == (tg + 1u) * nx) xb_add(&bar[XB_TOPGEN], 1u);
            else XB_SPIN(xb_ld(&bar[XB_TOPGEN]) == tg, bar);
            __builtin_amdgcn_fence(__ATOMIC_ACQUIRE, "agent");
            xb_add(&bar[XB_XGEN(b.x)], 1u);
            asm volatile("s_waitcnt vmcnt(0)" ::: "memory");
        } else {
            XB_SPIN(xb_ld(&bar[XB_XGEN(b.x)]) == gen, bar);
            __builtin_amdgcn_fence(__ATOMIC_ACQUIRE, "agent");
            asm volatile("s_waitcnt vmcnt(0)" ::: "memory");
        }
    }
    __syncthreads();
}
#ifndef REP3A
#define REP3A 1
#endif
#ifndef REP2B
#define REP2B 1
#endif
#ifndef REP2A
#define REP2A 1
#endif
#ifndef REP6
#define REP6 1
#endif
#ifndef REP5
#define REP5 1
#endif
#ifndef REP0A
#define REP0A 1
#endif
#ifndef REP0B
#define REP0B 1
#endif
#ifndef REP0
#define REP0 1
#endif
#ifndef REP1
#define REP1 1
#endif
#ifndef REP2
#define REP2 1
#endif
#ifndef REP3
#define REP3 1
#endif
#ifndef REP4
#define REP4 1
#endif
constexpr int NWAVES = 8;
constexpr int BATCH = 4, SEQ = 4096, DM = 2048, M = BATCH * SEQ;
constexpr int PLE = 256;
constexpr int GH = 4, GDK = 128, GDV = 256, GRANK = 16;
constexpr int SH = 8, SDH = 128;
constexpr int DIN_SRC = 7184;
constexpr int LDU = 7168;
constexpr int UQ = 0, UK = 512, UV = 1024, UG = 2048, USQ = 3072, USK = 4096, USV = 5120, USG = 6144;
constexpr float EPS = 1e-6f;
constexpr float SB_T = 30.0f;

constexpr size_t MiB = 1u << 20;
constexpr size_t WS_CTL = 0, CTL_ZERO_BYTES = 1 * MiB;
constexpr size_t WS_WIN = 2 * MiB, WS_WOUT = 30 * MiB, WS_WG = 38 * MiB, WS_WP = 46 * MiB;
constexpr size_t WS_RS = 47 * MiB, WS_GLR = 48 * MiB, WS_PIN = 50 * MiB;
constexpr size_t WS_BDEC = 64 * MiB;
constexpr size_t WS_XB = 64 * MiB;
constexpr size_t WS_U = 128 * MiB;
constexpr size_t WS_PB = 128 * MiB;
constexpr size_t WS_MIX = 192 * MiB;
constexpr size_t WS_HRES = 352 * MiB;
constexpr size_t WS_MIXIN = 352 * MiB;
constexpr size_t WS_DS = 416 * MiB, WS_SIN = 448 * MiB, WS_GS = 480 * MiB;
constexpr size_t WS_END = 481 * MiB;
constexpr int CW_BAR = 4096;

constexpr int RING_OFF = 0, RING_BYTES = 131072;
constexpr int LDSCTL_OFF = 152064, MISC_OFF = LDSCTL_OFF + 320;
constexpr int LDS_BYTES = 153600;
constexpr int P0_TAB_OFF = 69632, P0_PART_OFF = 135168;

struct Frame {
    LAS unsigned char* lds;
    volatile LAS unsigned* MISC;
    gu32* ctl;
    int vcu, G, wave;
};
#define F_WAVE F.wave
#define PHASE_IDS() int lane_o; asm volatile("v_mbcnt_lo_u32_b32 %0, -1, 0\n\tv_mbcnt_hi_u32_b32 %0, -1, %0" : "=v"(lane_o)); \
    const int lane = lane_o, wave = F_WAVE, tid = wave * 64 + lane; (void)tid; (void)lane; (void)wave
__device__ __forceinline__ float wave_sum(float v) {
#pragma unroll
    for (int o = 1; o < 64; o <<= 1) v += __shfl_xor(v, o);
    return v;
}
__device__ __forceinline__ float bf_lo(unsigned w) { return __uint_as_float(w << 16); }
__device__ __forceinline__ float bf_hi(unsigned w) { return __uint_as_float(w & 0xffff0000u); }
__device__ __forceinline__ float bf2f(bf16 b) { return __uint_as_float(((unsigned)b) << 16); }

__device__ __forceinline__ void p0_item64(const float* W, int ldw, int K, bf16* WT, int src_col0, int dst_col0, int k0, const float* gk, LAS float* scr, int lane) {
#pragma unroll 8
    for (int i = 0; i < 16; ++i) { const int kk = 4 * i + (lane >> 4), c4 = 4 * (lane & 15);
        f32x4 v = *(const GAS f32x4*)(W + (size_t)(k0 + kk) * ldw + src_col0 + c4); if (gk) { const float g = gk[k0 + kk]; v = v * g; }
        LAS float* d = scr + kk * 65 + c4; d[0] = v.x; d[1] = v.y; d[2] = v.z; d[3] = v.w; }
    LDS_WAIT(); asm volatile("" ::: "memory");
    const int c = lane & 7, tile0 = dst_col0 & ~255, wc = (dst_col0 >> 6) & 3;
#pragma unroll
    for (int j = 0; j < 8; ++j) { const int r64 = 8 * j + (lane >> 3), bj = r64 >> 5, rho = r64 & 31, csrc = 16 * (rho >> 3) + 8 * bj + (rho & 7);
        const LAS float* s = scr + (8 * c) * 65 + csrc;
        v4u o; o.x = pk2(s[0 * 65], s[1 * 65]); o.y = pk2(s[2 * 65], s[3 * 65]); o.z = pk2(s[4 * 65], s[5 * 65]); o.w = pk2(s[6 * 65], s[7 * 65]);
        *(GAS v4u*)(WT + (size_t)(tile0 + 128 * bj + 32 * wc + rho) * K + k0 + 8 * c) = o; }
    LDS_WAIT(); asm volatile("" ::: "memory");
}

struct Args { const float* in[12]; float* out; unsigned char* ws; };
typedef short v4i16_t __attribute__((ext_vector_type(4)));
namespace gla {
typedef short s16x4 __attribute__((ext_vector_type(4)));
typedef float f32x16 __attribute__((ext_vector_type(16)));
typedef float f32x2_t __attribute__((ext_vector_type(2)));
typedef __bf16 bf16x2_t __attribute__((ext_vector_type(2)));
constexpr int L_Q = 0, L_K = 16384, L_L = 32768, L_V = 49152, L_O = 81920, L_TOT = 147456, L_GC = 151552, L_END = 152064;
constexpr float L2E = 1.4426950408889634f;
__device__ __forceinline__ unsigned off_b(unsigned row, unsigned ch) { return 256u * row + 16u * (ch ^ (((row & 3u) << 2) | ((row >> 2) & 3u))); }
__device__ __forceinline__ int crow(int i, int hh) { return (i & 3) + 8 * (i >> 2) + 4 * hh; }
__device__ __forceinline__ unsigned cvtpk(float lo, float hi) { f32x2_t v = {lo, hi}; bf16x2_t b = __builtin_convertvector(v, bf16x2_t); return __builtin_bit_cast(unsigned, b); }
__device__ __forceinline__ s16x4 vtr(LAS const unsigned char* p) { return __builtin_bit_cast(s16x4, __builtin_amdgcn_ds_read_tr16_b64_v4i16((LAS v4i16_t*)p)); }
__device__ __forceinline__ bf16x8 tr_frag(LAS const unsigned char* img, int lane, int c, int ks) {
    const unsigned hh = lane >> 5, blk = (lane >> 4) & 1, q = (lane & 15) >> 2, p = lane & 3;
    const unsigned ch = 4u * c + 2u * blk + (p >> 1);
    const unsigned r0 = 16u * ks + 4u * hh + q, r1 = r0 + 8u;
    const s16x4 lo = vtr(img + off_b(r0, ch) + 8u * (p & 1)), hi = vtr(img + off_b(r1, ch) + 8u * (p & 1));
    return __builtin_shufflevector(lo, hi, 0, 1, 2, 3, 4, 5, 6, 7);
}
__device__ __forceinline__ bf16x8 row_frag(LAS const unsigned char* img, int row, int s, int hh) { return *(const LAS bf16x8*)(img + off_b(row, 2 * s + hh)); }
__device__ __forceinline__ bf16x8 pack8(const f32x16& x, int s) {
    v4u p; p.x = cvtpk(x[8 * s + 0], x[8 * s + 1]); p.y = cvtpk(x[8 * s + 2], x[8 * s + 3]); p.z = cvtpk(x[8 * s + 4], x[8 * s + 5]); p.w = cvtpk(x[8 * s + 6], x[8 * s + 7]);
    return __builtin_bit_cast(bf16x8, p);
}
#define GLA_MFMA(a, b, c) __builtin_amdgcn_mfma_f32_32x32x16_bf16((a), (b), (c), 0, 0, 0)
#define GLA_BAR() asm volatile("s_waitcnt lgkmcnt(0)\n\ts_barrier" ::: "memory")

template <int PASS  >
__device__ __forceinline__ void item(Frame& F, const Args& A, int it) {
    PHASE_IDS();
    LAS unsigned char* lds = F.lds;
    const float* w_a2 = A.in[4]; const float* b_a = A.in[5]; const float* g_head = A.in[6];
    const bf16* U = (const bf16*)(A.ws + WS_U); const float* GLR = (const float*)(A.ws + WS_GLR); bf16* MIXIN = (bf16*)(A.ws + WS_MIXIN);
    float* BDEC = (float*)(A.ws + WS_BDEC);
    float* DS = (float*)(A.ws + WS_DS); float* SIN = (float*)(A.ws + WS_SIN); float* GS = (float*)(A.ws + WS_GS);
    const int sc = it & 15, h = (it >> 4) & 3, b = it >> 6;
    const int hh0 = lane >> 5, r320 = lane & 31; int lane_s = lane;
    LAS unsigned char* imgQ = lds + L_Q; LAS unsigned char* imgK = lds + L_K; LAS unsigned char* imgL = lds + L_L; LAS unsigned char* imgV = lds + L_V;
    LAS float* Ot = (LAS float*)(lds + L_O); LAS float* tot = (LAS float*)(lds + L_TOT); LAS float* gc = (LAS float*)(lds + L_GC);
    f32x16 St[4];
#pragma unroll
    for (int db = 0; db < 4; ++db)
#pragma unroll
        for (int i = 0; i < 16; ++i) St[db][i] = PASS ? SIN[(size_t)it * 32768 + (size_t)(32 * db + crow(i, hh0)) * 256 + 32 * wave + r320] : 0.f;
    float blsum[2] = {0.f, 0.f};
    float g0, g1; unsigned kv[8], qv[8]; unsigned long long gpre[8]; f32x2_t bd[8], ball;
#define GLA_LOAD_QK(mm) do { const size_t mq_ = (mm); if (!PASS) { g0 = GLR[(mq_ + 8 * wave) * 16 + lane]; g1 = GLR[(mq_ + 8 * wave) * 16 + 64 + lane]; }     \
        _Pragma("unroll") for (int i = 0; i < 8; ++i) { kv[i] = *(const GAS unsigned*)(U + (mq_ + 8 * wave + i) * LDU + UK + h * 128 + 2 * lane); \
            if (PASS) qv[i] = *(const GAS unsigned*)(U + (mq_ + 8 * wave + i) * LDU + UQ + h * 128 + 2 * lane); } } while (0)
#define GLA_LOAD_B(mm) do { const size_t mb_ = (mm); ball = *(const GAS f32x2_t*)(BDEC + (mb_ + 63) * 512 + h * 128 + 2 * lane); \
        _Pragma("unroll") for (int i = 0; i < 8; ++i) bd[i] = *(const GAS f32x2_t*)(BDEC + (mb_ + 8 * wave + i) * 512 + h * 128 + 2 * lane); } while (0)
#define GLA_LOAD_V(mm) do { const size_t mv_ = (mm); _Pragma("unroll") for (int j = 0; j < 4; ++j) { const int pidx = 4 * wave + j, eh = pidx >> 4, rg = pidx & 15; \
            const unsigned row = 4u * rg + ((unsigned)lane >> 4), ch = ((unsigned)lane & 15u) ^ (((row & 3u) << 2) | ((row >> 2) & 3u)); \
            __builtin_amdgcn_global_load_lds((const GAS unsigned*)(U + (mv_ + row) * LDU + UV + h * 256 + eh * 128 + 8 * ch), (LAS unsigned*)(imgV + eh * 16384 + 1024 * rg), 16, 0, 0); } } while (0)
    { const size_t mf = (size_t)b * SEQ + sc * 256; GLA_LOAD_QK(mf); GLA_LOAD_V(mf); if (PASS) GLA_LOAD_B(mf); }
    for (int c4 = 0; c4 < 4; ++c4) {
        const size_t m0 = (size_t)b * SEQ + sc * 256 + c4 * 64;
        { int l1 = lane_o; asm volatile("" : "+v"(l1)); lane_s = l1; }
#define lane lane_s
#define tid (wave * 64 + lane_s)
        const unsigned d0 = 2u * lane, pq = (d0 & ~12u) | ((d0 & 4u) << 1) | ((d0 & 8u) >> 1);
        float cs[8][2]; float pref[2] = {0.f, 0.f}, all[2] = {0.f, 0.f};
        if (!PASS) {
        const GAS float* w_a2o = (const GAS float*)w_a2; asm volatile("" : "+s"(w_a2o));
        float wa[2][16], ba[2];
#pragma unroll
        for (int c = 0; c < 2; ++c) { ba[c] = b_a[h * 128 + 2 * lane + c];
#pragma unroll
            for (int r = 0; r < 16; ++r) wa[c][r] = w_a2o[r * 512 + h * 128 + 2 * lane + c]; }
#pragma unroll
        for (int i = 0; i < 8; ++i) {
            float pre0 = ba[0], pre1 = ba[1];
#pragma unroll
            for (int r = 0; r < 16; ++r) { const float g = __uint_as_float((unsigned)__builtin_amdgcn_readlane((int)__float_as_uint(i < 4 ? g0 : g1), (i & 3) * 16 + r)); pre0 += g * wa[0][r]; pre1 += g * wa[1][r]; }
            const float l0 = (fminf(pre0, 0.f) * L2E - __builtin_amdgcn_logf(1.0f + __builtin_amdgcn_exp2f(-fabsf(pre0) * L2E))) * (1.0f / 16.0f);
            const float l1 = (fminf(pre1, 0.f) * L2E - __builtin_amdgcn_logf(1.0f + __builtin_amdgcn_exp2f(-fabsf(pre1) * L2E))) * (1.0f / 16.0f);
            cs[i][0] = (i ? cs[i - 1][0] : 0.f) + l0; cs[i][1] = (i ? cs[i - 1][1] : 0.f) + l1;
        }
        *(LAS f32x2_t*)(tot + wave * 128 + 2 * lane) = (f32x2_t){cs[7][0], cs[7][1]};
        GLA_BAR();
#pragma unroll
        for (int w2 = 0; w2 < 8; ++w2) { const f32x2_t tv = *(const LAS f32x2_t*)(tot + w2 * 128 + 2 * lane); all[0] += tv.x; all[1] += tv.y; if (w2 < wave) { pref[0] += tv.x; pref[1] += tv.y; } }
#pragma unroll
        for (int i = 0; i < 8; ++i) *(GAS f32x2_t*)(BDEC + (m0 + 8 * wave + i) * 512 + h * 128 + 2 * lane) = (f32x2_t){pref[0] + cs[i][0], pref[1] + cs[i][1]};
        } else {
#pragma unroll
            for (int i = 0; i < 8; ++i) { cs[i][0] = bd[i].x; cs[i][1] = bd[i].y; }
            all[0] = ball.x; all[1] = ball.y;
        }
        const float gl0 = __builtin_amdgcn_exp2f(all[0]), gl1 = __builtin_amdgcn_exp2f(all[1]);
        blsum[0] += all[0]; blsum[1] += all[1];
        if (wave == 0) *(LAS f32x2_t*)(gc + 2 * lane) = (f32x2_t){gl0, gl1};
#pragma unroll
        for (int i = 0; i < 8; ++i) {
            const int t = 8 * wave + i;
            const float b0 = pref[0] + cs[i][0], b1 = pref[1] + cs[i][1];
            const float en0 = __builtin_amdgcn_exp2f(-b0), en1 = __builtin_amdgcn_exp2f(-b1);
            const float k0 = bf_lo(kv[i]), k1 = bf_hi(kv[i]);
            *(LAS unsigned*)(imgL + off_b(t, d0 >> 3) + (d0 & 7u) * 2u) = cvtpk(k0 * (en0 * gl0), k1 * (en1 * gl1));
            if (PASS) {
                const float eb0 = __builtin_amdgcn_exp2f(b0), eb1 = __builtin_amdgcn_exp2f(b1);
                const float q0 = bf_lo(qv[i]) * 0.08838834764831845f, q1 = bf_hi(qv[i]) * 0.08838834764831845f;
                *(LAS unsigned*)(imgK + off_b(t, pq >> 3) + (pq & 7u) * 2u) = cvtpk(k0 * en0, k1 * en1);
                *(LAS unsigned*)(imgQ + off_b(t, pq >> 3) + (pq & 7u) * 2u) = cvtpk(q0 * eb0, q1 * eb1);
            }
        }
        asm volatile("s_waitcnt vmcnt(0)" ::: "memory"); GLA_BAR();
        { int l2 = lane_o; asm volatile("" : "+v"(l2)); lane_s = l2; }
        const int hh = lane >> 5, r32 = lane & 31;
        if (c4 < 3) GLA_LOAD_QK(m0 + 64);
        LAS const unsigned char* myV = imgV + (wave >> 2) * 16384;
        bf16x8 Vf[4];
#pragma unroll
        for (int ks = 0; ks < 4; ++ks) Vf[ks] = tr_frag(myV, lane, wave & 3, ks);
        if (PASS) {
            bf16x8 SP[4][2];
#pragma unroll
            for (int db = 0; db < 4; ++db) { SP[db][0] = pack8(St[db], 0); SP[db][1] = pack8(St[db], 1); }
#pragma unroll
            for (int tb = 0; tb < 2; ++tb) {
                bf16x8 Qf[8];
#pragma unroll
                for (int s = 0; s < 8; ++s) Qf[s] = row_frag(imgQ, 32 * tb + r32, s, hh);
                f32x16 o;
#pragma unroll
                for (int i = 0; i < 16; ++i) o[i] = 0.f;
#pragma unroll
                for (int db = 0; db < 4; ++db) { o = GLA_MFMA(Qf[2 * db], SP[db][0], o); o = GLA_MFMA(Qf[2 * db + 1], SP[db][1], o); }
#pragma unroll
                for (int tb2 = 0; tb2 <= tb; ++tb2) {
                    f32x16 pt;
#pragma unroll
                    for (int i = 0; i < 16; ++i) pt[i] = 0.f;
#pragma unroll
                    for (int s = 0; s < 8; ++s) pt = GLA_MFMA(row_frag(imgK, 32 * tb2 + r32, s, hh), Qf[s], pt);
                    if (tb2 == tb) {
#pragma unroll
                        for (int i = 0; i < 16; ++i) pt[i] = (crow(i, hh) <= r32) ? pt[i] : 0.f;
                    }
                    o = GLA_MFMA(pack8(pt, 0), Vf[2 * tb2], o); o = GLA_MFMA(pack8(pt, 1), Vf[2 * tb2 + 1], o);
                }
#pragma unroll
                for (int i = 0; i < 16; ++i) Ot[(32 * tb + crow(i, hh)) * 256 + 32 * wave + r32] = o[i];
            }
        }
#pragma unroll
        for (int db = 0; db < 4; ++db) {
#pragma unroll
            for (int g4 = 0; g4 < 4; ++g4) { const f32x4 gv = *(const LAS f32x4*)(gc + 32 * db + 8 * g4 + 4 * hh);
                St[db][4 * g4 + 0] *= gv.x; St[db][4 * g4 + 1] *= gv.y; St[db][4 * g4 + 2] *= gv.z; St[db][4 * g4 + 3] *= gv.w; }
#pragma unroll
            for (int ks = 0; ks < 4; ++ks) St[db] = GLA_MFMA(tr_frag(imgL, lane, db, ks), Vf[ks], St[db]);
        }
        GLA_BAR();
        { int l3 = lane_o; asm volatile("" : "+v"(l3)); lane_s = l3; }
        if (PASS) {
#pragma unroll
            for (int rr = 0; rr < 8; ++rr) gpre[rr] = *(const GAS unsigned long long*)(U + (m0 + 8 * wave + rr) * LDU + UG + h * 256 + 4 * lane);
        }
        if (c4 < 3) { GLA_LOAD_V(m0 + 64); if (PASS) GLA_LOAD_B(m0 + 64); }
        if (PASS) {
            const f32x4 gh = *(const GAS f32x4*)(g_head + 4 * lane);
#pragma unroll
            for (int rr = 0; rr < 8; ++rr) { const int t = 8 * wave + rr;
                const f32x4 ov = *(const LAS f32x4*)(Ot + t * 256 + 4 * lane);
                float ss = (ov.x * ov.x + ov.y * ov.y) + (ov.z * ov.z + ov.w * ov.w);
                ss = wave_sum(ss); const float rn = 1.0f / sqrtf(ss * (1.0f / 256.0f) + EPS);
                const unsigned long long gw = gpre[rr];
                const float ga = bf_lo((unsigned)gw), gb = bf_hi((unsigned)gw), gcc = bf_lo((unsigned)(gw >> 32)), gd = bf_hi((unsigned)(gw >> 32));
                const float v0 = ov.x * rn * gh.x * (ga / (1.0f + __expf(-ga))), v1 = ov.y * rn * gh.y * (gb / (1.0f + __expf(-gb)));
                const float v2 = ov.z * rn * gh.z * (gcc / (1.0f + __expf(-gcc))), v3 = ov.w * rn * gh.w * (gd / (1.0f + __expf(-gd)));
                *(GAS unsigned long long*)(MIXIN + (m0 + t) * DM + h * 256 + 4 * lane) = (unsigned long long)cvtpk(v0, v1) | ((unsigned long long)cvtpk(v2, v3) << 32);
                if (rr & 1) asm volatile("" ::: "memory"); }
        }
    }
#undef lane
#undef tid
#undef GLA_LOAD_QK
#undef GLA_LOAD_V
#undef GLA_LOAD_B
    if (!PASS) {
#pragma unroll
        for (int db = 0; db < 4; ++db)
#pragma unroll
            for (int i = 0; i < 16; ++i) DS[(size_t)it * 32768 + (size_t)(32 * db + crow(i, hh0)) * 256 + 32 * wave + r320] = St[db][i];
        if (wave == 0) *(GAS f32x2_t*)(GS + (size_t)it * 128 + 2 * lane) = (f32x2_t){__builtin_amdgcn_exp2f(blsum[0]), __builtin_amdgcn_exp2f(blsum[1])};
    }
    __syncthreads();
}
__device__ __forceinline__ void scan(Frame& F, const Args& A) {
    PHASE_IDS();
    const int gtid = (int)blockIdx.x * (NWAVES * 64) + tid, nthreads = F.G * NWAVES * 64;
    const float* DS = (const float*)(A.ws + WS_DS); float* SIN = (float*)(A.ws + WS_SIN); const float* GS = (const float*)(A.ws + WS_GS);
    for (int idx = gtid; idx < 16 * 8192; idx += nthreads) {
        const int bh = idx >> 13, e4 = idx & 8191, d = e4 >> 6;
        f32x4 cur = (f32x4){0.f, 0.f, 0.f, 0.f};
#pragma unroll 4
        for (int s = 0; s < 16; ++s) { const size_t itx = (size_t)bh * 16 + s;
            *((GAS f32x4*)(SIN + itx * 32768) + e4) = cur;
            if (s < 15) { const float g = GS[itx * 128 + d]; const f32x4 dv = *((const GAS f32x4*)(DS + itx * 32768) + e4); cur = cur * g + dv; } }
    }
}
}
namespace sb {
using gla::f32x16; using gla::off_b; using gla::crow; using gla::tr_frag; using gla::row_frag; using gla::pack8; using gla::L2E;
constexpr float T2 = 30.0f * 1.4426950408889634f;
__device__ __forceinline__ void wave_item(Frame& F, const Args& A, int wi) {
    PHASE_IDS();
    const bf16* U = (const bf16*)(A.ws + WS_U); bf16* MIXIN = (bf16*)(A.ws + WS_MIXIN);
    const int hh0 = lane >> 5, r320 = lane & 31;
    const int kt0 = wi & 127, h = (wi >> 7) & 7, b = wi >> 10, t0 = 32 * kt0;
    LAS unsigned char* imgK = F.lds + wave * 16384; LAS unsigned char* imgV = imgK + 8192; LAS float* Of = (LAS float*)imgK;
    const size_t rowb = (size_t)b * SEQ;
    bf16x8 Qf[8];
#pragma unroll
    for (int s = 0; s < 8; ++s) Qf[s] = *(const GAS bf16x8*)(U + (rowb + t0 + r320) * LDU + USQ + h * 128 + 16 * s + 8 * hh0);
    f32x16 o[4];
#pragma unroll
    for (int c = 0; c < 4; ++c)
#pragma unroll
        for (int i = 0; i < 16; ++i) o[c][i] = 0.f;
    float R = 0.f;
    const float C = 0.08838834764831845f * L2E;
    v4u kx[8], vx[8];
#define SB_LOADK(KT) do { const int j0_ = 32 * (KT); _Pragma("unroll") for (int i = 0; i < 8; ++i) { const int n = lane + 64 * i, row = n >> 4, ch = n & 15; \
        kx[i] = *(const GAS v4u*)(U + (rowb + j0_ + row) * LDU + USK + h * 128 + 8 * ch); } } while (0)
#define SB_LOADV(KT) do { const int j0_ = 32 * (KT); _Pragma("unroll") for (int i = 0; i < 8; ++i) { const int n = lane + 64 * i, row = n >> 4, ch = n & 15; \
        vx[i] = *(const GAS v4u*)(U + (rowb + j0_ + row) * LDU + USV + h * 128 + 8 * ch); } } while (0)
    SB_LOADK(kt0);
    int lane_t = lane;
    for (int kt = kt0; kt >= 0; --kt) {
        { int lt = lane_o; asm volatile("" : "+v"(lt)); lane_t = lt; }
#define lane lane_t
        const int hh = lane >> 5, r32 = lane & 31;
#pragma unroll
        for (int i = 0; i < 8; ++i) { const int n = lane + 64 * i, row = n >> 4, ch = n & 15; *(LAS v4u*)(imgK + off_b(row, ch)) = kx[i]; }
        SB_LOADV(kt);
        f32x16 sacc;
#pragma unroll
        for (int i = 0; i < 16; ++i) sacc[i] = 0.f;
#pragma unroll
        for (int s = 0; s < 8; ++s) sacc = GLA_MFMA(row_frag(imgK, r32, s, hh), Qf[s], sacc);
        const bool diag = (kt == kt0);
        float lk[16], G[4], Gp[4];
#pragma unroll
        for (int i = 0; i < 16; ++i) { const float z2 = sacc[i] * C; const bool act = !diag || (crow(i, hh) < r32);
            const float sp = fmaxf(z2, 0.f) + __builtin_amdgcn_logf(1.0f + __builtin_amdgcn_exp2f(-fabsf(z2)));
            lk[i] = act ? -sp : 0.f; sacc[i] = act ? z2 : -3.0e38f; }
#pragma unroll
        for (int g = 0; g < 4; ++g) { G[g] = (lk[4 * g] + lk[4 * g + 1]) + (lk[4 * g + 2] + lk[4 * g + 3]); Gp[g] = __shfl_xor(G[g], 32); }
        float acc = R;
#pragma unroll
        for (int g = 3; g >= 0; --g) {
            const float offg = acc + (hh == 0 ? Gp[g] : 0.f);
            const float r3 = offg + lk[4 * g + 3], r2 = r3 + lk[4 * g + 2], r1 = r2 + lk[4 * g + 1], r0 = r1 + lk[4 * g];
            sacc[4 * g + 3] = __builtin_amdgcn_exp2f(sacc[4 * g + 3] + r3); sacc[4 * g + 2] = __builtin_amdgcn_exp2f(sacc[4 * g + 2] + r2);
            sacc[4 * g + 1] = __builtin_amdgcn_exp2f(sacc[4 * g + 1] + r1); sacc[4 * g] = __builtin_amdgcn_exp2f(sacc[4 * g] + r0);
            acc += G[g] + Gp[g];
        }
        R = acc;
#pragma unroll
        for (int i = 0; i < 8; ++i) { const int n = lane + 64 * i, row = n >> 4, ch = n & 15; *(LAS v4u*)(imgV + off_b(row, ch)) = vx[i]; }
        if (kt > 0) SB_LOADK(kt - 1);
        const bf16x8 w0 = pack8(sacc, 0), w1 = pack8(sacc, 1);
#pragma unroll
        for (int c = 0; c < 4; ++c) { o[c] = GLA_MFMA(w0, tr_frag(imgV, lane, c, 0), o[c]); o[c] = GLA_MFMA(w1, tr_frag(imgV, lane, c, 1), o[c]); }
        if (__ballot(R > -T2) == 0ull) break;
    }
#undef lane
#undef SB_LOADK
#undef SB_LOADV
#pragma unroll
    for (int c = 0; c < 4; ++c)
#pragma unroll
        for (int i = 0; i < 16; ++i) Of[crow(i, hh0) * 128 + 32 * c + r320] = o[c][i];
#pragma unroll
    for (int pz = 0; pz < 8; ++pz) { const int row = 4 * pz + (lane >> 4), c8 = 8 * (lane & 15);
        const f32x4 a = *(const LAS f32x4*)(Of + row * 128 + c8), bq = *(const LAS f32x4*)(Of + row * 128 + c8 + 4);
        const v4u gw = *(const GAS v4u*)(U + (rowb + t0 + row) * LDU + USG + h * 128 + c8);
        const float ov[8] = {a.x, a.y, a.z, a.w, bq.x, bq.y, bq.z, bq.w}; const unsigned gws[4] = {gw.x, gw.y, gw.z, gw.w}; unsigned ow[4];
#pragma unroll
        for (int q = 0; q < 4; ++q) { const float g0 = bf_lo(gws[q]), g1 = bf_hi(gws[q]);
            ow[q] = gla::cvtpk(ov[2 * q] * (g0 / (1.0f + __expf(-g0))), ov[2 * q + 1] * (g1 / (1.0f + __expf(-g1)))); }
        v4u w; w.x = ow[0]; w.y = ow[1]; w.z = ow[2]; w.w = ow[3];
        *(GAS v4u*)(MIXIN + (rowb + t0 + row) * DM + 1024 + h * 128 + c8) = w; }
}
}

__device__ __forceinline__ void p0_prologue(Frame& F, const Args& A) {
    PHASE_IDS();
    const float* x = A.in[0]; const float* p = A.in[1]; const float* g_pre = A.in[2]; const float* w_in = A.in[3];
    const float* w_out = A.in[7]; const float* w_g = A.in[9]; const float* w_p = A.in[11];
    unsigned char* ws = A.ws;
    bf16* WinT = (bf16*)(ws + WS_WIN); bf16* WoutT = (bf16*)(ws + WS_WOUT); bf16* WgT = (bf16*)(ws + WS_WG); bf16* WpT = (bf16*)(ws + WS_WP);
    bf16* XB = (bf16*)(ws + WS_XB); bf16* PIN = (bf16*)(ws + WS_PIN); float* RS = (float*)(ws + WS_RS); float* GLR = (float*)(ws + WS_GLR);
    LAS float* scr = (LAS float*)(F.lds + RING_OFF + wave * 16640);
    const int gw = F.vcu * NWAVES + wave, NGW = F.G * NWAVES;
    for (int repa = 0; repa < REP0A; ++repa) {
    constexpr int I_IN = (DM / 64) * (LDU / 64), I_SQ = (DM / 64) * (DM / 64), I_P = (PLE / 64) * (DM / 64);
    constexpr int NITEMS = I_IN + 2 * I_SQ + I_P;
    for (int it = gw; it < NITEMS; it += NGW) {
        int r = it;
        if (r < I_IN) { const int ng = LDU / 64, kb = r / ng, g = r % ng, nd = 64 * g; p0_item64(w_in, DIN_SRC, DM, WinT, nd + (nd >= 3072 ? 16 : 0), nd, 64 * kb, g_pre, scr, lane); continue; }
        r -= I_IN;
        if (r < I_SQ) { const int ng = DM / 64, kb = r / ng, g = r % ng; p0_item64(w_out, DM, DM, WoutT, 64 * g, 64 * g, 64 * kb, nullptr, scr, lane); continue; }
        r -= I_SQ;
        if (r < I_SQ) { const int ng = DM / 64, kb = r / ng, g = r % ng; p0_item64(w_g, DM, DM, WgT, 64 * g, 64 * g, 64 * kb, nullptr, scr, lane); continue; }
        r -= I_SQ;
        { const int ng = DM / 64, kb = r / ng, g = r % ng; p0_item64(w_p, DM, PLE, WpT, 64 * g, 64 * g, 64 * kb, nullptr, scr, lane); }
    }
    for (int m = gw; m < M; m += NGW) {
        const f32x4 v = *((const GAS f32x4*)(p + (size_t)m * PLE) + lane);
        *((GAS unsigned long long*)(PIN + (size_t)m * PLE) + lane) = (unsigned long long)pk2(v.x, v.y) | ((unsigned long long)pk2(v.z, v.w) << 32);
    }
    }
    for (int repb = 0; repb < REP0B; ++repb)
    {
        LAS v4u* tab = (LAS v4u*)(F.lds + P0_TAB_OFF); LAS float* part = (LAS float*)(F.lds + P0_PART_OFF);
        __syncthreads();
        for (int e = tid; e < 64 * 64; e += NWAVES * 64) { const int kb = e >> 6, ln = e & 63, k0 = 32 * kb + 8 * (ln >> 4), n = ln & 15; float wv[8];
#pragma unroll
            for (int jj = 0; jj < 8; ++jj) wv[jj] = w_in[(size_t)(k0 + jj) * DIN_SRC + 3072 + n] * g_pre[k0 + jj];
            v4u o; o.x = pk2(wv[0], wv[1]); o.y = pk2(wv[2], wv[3]); o.z = pk2(wv[4], wv[5]); o.w = pk2(wv[6], wv[7]); tab[e] = o; }
        __syncthreads();
        for (int rb = F.vcu; rb < M / 64; rb += F.G) {
            const int rg = wave & 3, kh = wave >> 2, row = 64 * rb + 16 * rg + (lane & 15), kq = lane >> 4;
            const GAS f32x4* xr = (const GAS f32x4*)(x + (size_t)row * DM + 1024 * kh + 8 * kq);
            GAS v4u* xo = (GAS v4u*)(XB + (size_t)row * DM + 1024 * kh + 8 * kq);
            f32x4 acc = (f32x4){0.f, 0.f, 0.f, 0.f}; float ss = 0.f;
#pragma unroll 8
            for (int kb = 0; kb < 32; ++kb) {
                const f32x4 a = xr[8 * kb], c = xr[8 * kb + 1];
                ss += (a.x * a.x + a.y * a.y) + (a.z * a.z + a.w * a.w) + (c.x * c.x + c.y * c.y) + (c.z * c.z + c.w * c.w);
                v4u pa; pa.x = gla::cvtpk(a.x, a.y); pa.y = gla::cvtpk(a.z, a.w); pa.z = gla::cvtpk(c.x, c.y); pa.w = gla::cvtpk(c.z, c.w);
                xo[4 * kb] = pa;
                const v4u pb = tab[(32 * kh + kb) * 64 + lane];
                acc = __builtin_amdgcn_mfma_f32_16x16x32_bf16(__builtin_bit_cast(bf16x8, pa), __builtin_bit_cast(bf16x8, pb), acc, 0, 0, 0);
            }
            ss += __shfl_xor(ss, 16); ss += __shfl_xor(ss, 32);
            if (kh == 1) { LAS float* pp = part + (rg * 64 + lane) * 5; pp[0] = acc[0]; pp[1] = acc[1]; pp[2] = acc[2]; pp[3] = acc[3]; pp[4] = ss; }
            __syncthreads();
            if (kh == 0) { const LAS float* pp = part + (rg * 64 + lane) * 5; acc[0] += pp[0]; acc[1] += pp[1]; acc[2] += pp[2]; acc[3] += pp[3]; ss += pp[4];
                const float r = 1.0f / sqrtf(ss * (1.0f / DM) + EPS);
#pragma unroll
                for (int q = 0; q < 4; ++q) { const float rq = __shfl(r, 4 * kq + q); GLR[(size_t)(64 * rb + 16 * rg + 4 * kq + q) * 16 + (lane & 15)] = acc[q] * rq; }
                if (lane < 16) RS[64 * rb + 16 * rg + lane] = r; }
            __syncthreads();
        }
    }
}

__device__ __forceinline__ void p5_postnorm(Frame& F, const Args& A) {
    PHASE_IDS();
    const float* x = A.in[0]; const float* g_post = A.in[8]; const bf16* mixb = (const bf16*)(A.ws + WS_MIX); bf16* HB = (bf16*)(A.ws + WS_XB);
    const int gw = F.vcu * NWAVES + wave, NGW = F.G * NWAVES;
    for (int m = gw; m < M; m += NGW) {
        const GAS v4u* mr = (const GAS v4u*)(mixb + (size_t)m * DM) + lane;
        const GAS f32x4* xr = (const GAS f32x4*)(x + (size_t)m * DM) + 2 * lane;
        v4u mv[4]; f32x4 xa[4], xb[4]; float ss = 0.f;
#pragma unroll
        for (int j = 0; j < 4; ++j) { mv[j] = mr[64 * j]; xa[j] = xr[128 * j]; xb[j] = xr[128 * j + 1]; }
        float mf[4][8];
#pragma unroll
        for (int j = 0; j < 4; ++j) { const unsigned w4[4] = {mv[j].x, mv[j].y, mv[j].z, mv[j].w};
#pragma unroll
            for (int q = 0; q < 4; ++q) { mf[j][2 * q] = bf_lo(w4[q]); mf[j][2 * q + 1] = bf_hi(w4[q]); ss += mf[j][2 * q] * mf[j][2 * q] + mf[j][2 * q + 1] * mf[j][2 * q + 1]; } }
        ss = wave_sum(ss); const float r = 1.0f / sqrtf(ss * (1.0f / DM) + EPS);
        GAS v4u* ho = (GAS v4u*)(HB + (size_t)m * DM) + lane;
#pragma unroll
        for (int j = 0; j < 4; ++j) { const f32x4 ga = *((const GAS f32x4*)g_post + 2 * lane + 128 * j), gb = *((const GAS f32x4*)g_post + 2 * lane + 128 * j + 1);
            v4u o; o.x = gla::cvtpk(xa[j].x + mf[j][0] * r * ga.x, xa[j].y + mf[j][1] * r * ga.y); o.y = gla::cvtpk(xa[j].z + mf[j][2] * r * ga.z, xa[j].w + mf[j][3] * r * ga.w);
            o.z = gla::cvtpk(xb[j].x + mf[j][4] * r * gb.x, xb[j].y + mf[j][5] * r * gb.y); o.w = gla::cvtpk(xb[j].z + mf[j][6] * r * gb.z, xb[j].w + mf[j][7] * r * gb.w);
            ho[64 * j] = o; }
    }
}

__global__ void __launch_bounds__(NWAVES * 64, 2) fwd_megakernel(Args args) {
    extern __shared__ __attribute__((aligned(16))) unsigned char lds[];
    Frame F;
    F.lds = (LAS unsigned char*)lds;
    F.MISC = (volatile LAS unsigned*)(F.lds + MISC_OFF);
    F.wave = __builtin_amdgcn_readfirstlane(threadIdx.x >> 6);
    F.G = gridDim.x; { const int bx = blockIdx.x; F.vcu = (F.G % 8 == 0) ? (bx % 8) * (F.G / 8) + bx / 8 : bx; }
    unsigned char* ws = args.ws;
    F.ctl = (gu32*)(ws + WS_CTL);
    for (int u = threadIdx.x; u < (LDS_BYTES - LDSCTL_OFF) / 4; u += NWAVES * 64) ((LAS unsigned*)(F.lds + LDSCTL_OFF))[u] = 0u;
    __syncthreads();
    XcdBarrier bar = xcd_barrier_post((unsigned*)(F.ctl + CW_BAR), F.MISC + 8);

    bf16* WinT = (bf16*)(ws + WS_WIN); bf16* WoutT = (bf16*)(ws + WS_WOUT); bf16* WgT = (bf16*)(ws + WS_WG); bf16* WpT = (bf16*)(ws + WS_WP);
    bf16* XB = (bf16*)(ws + WS_XB); bf16* PIN = (bf16*)(ws + WS_PIN); float* RS = (float*)(ws + WS_RS);
    bf16* U = (bf16*)(ws + WS_U); bf16* PB = (bf16*)(ws + WS_PB); bf16* MIXIN = (bf16*)(ws + WS_MIXIN);

    for (int rep = 0; rep < REP0; ++rep) {
    p0_prologue(F, args);
    xcd_barrier(bar); }
    for (int rep = 0; rep < REP1; ++rep) {
    { pg8::Gemm g{XB, WinT, M, LDU, DM}; pg8::StaticOrder S; S.init(M, LDU, F.G, (int)blockIdx.x);
      pg8::EpiB16 E{U, LDU, RS};
      pg8::gemm_phase<pg8::EpiB16, pg8::StaticOrder, true, true>(F.lds + RING_OFF, g, S, E, F.wave); }
    xcd_barrier(bar); }
    for (int rep = 0; rep < REP2; ++rep) {
    for (int r2 = 0; r2 < REP2A; ++r2)
    for (int it = (int)blockIdx.x; it < BATCH * GH * 16; it += F.G) gla::item<0>(F, args, it);
    { const int gw = (int)blockIdx.x * NWAVES + F.wave, NGW = F.G * NWAVES;
      for (int r2 = 0; r2 < REP2B; ++r2)
      for (int wi = gw; wi < BATCH * SH * (SEQ / 32); wi += NGW) sb::wave_item(F, args, wi); }
    xcd_barrier(bar); }
    for (int rep = 0; rep < REP3; ++rep) {
    for (int r3 = 0; r3 < REP3A; ++r3) {
    gla::scan(F, args);
    xcd_barrier(bar); }
    for (int it = (int)blockIdx.x; it < BATCH * GH * 16; it += F.G) gla::item<1>(F, args, it);
    xcd_barrier(bar); }
    for (int rep = 0; rep < REP4; ++rep) {
    { pg8::Gemm g{MIXIN, WoutT, M, DM, DM}; pg8::StaticOrder S; S.init(M, DM, F.G, (int)blockIdx.x);
      pg8::EpiB16 E{(bf16*)(ws + WS_MIX), DM, nullptr};
      pg8::gemm_phase<pg8::EpiB16, pg8::StaticOrder, true, true>(F.lds + RING_OFF, g, S, E, F.wave); }
    { pg8::Gemm g{PIN, WpT, M, DM, PLE}; pg8::StaticOrder S; S.init(M, DM, F.G, (int)blockIdx.x);
      pg8::EpiB16 E{PB, DM, nullptr};
      pg8::gemm_phase<pg8::EpiB16, pg8::StaticOrder, true, true>(F.lds + RING_OFF, g, S, E, F.wave); }
    xcd_barrier(bar); }
    for (int rep = 0; rep < REP5; ++rep) {
    p5_postnorm(F, args);
    xcd_barrier(bar); }
    for (int rep = 0; rep < REP6; ++rep)
    { pg8::Gemm g{XB, WgT, M, DM, DM}; pg8::StaticOrder S; S.init(M, DM, F.G, (int)blockIdx.x);
      pg8::EpiFinal E{XB, args.out, PB, args.in[10], DM};
      pg8::gemm_phase<pg8::EpiFinal, pg8::StaticOrder, true, true>(F.lds + RING_OFF, g, S, E, F.wave); }
}

extern "C" void kernel_launch(void* const* d_in, const int* in_sizes, int n_in, void* d_out, int out_size, void* d_ws, size_t ws_size, hipStream_t stream) {
    static int grid = 0;
    if (grid == 0) {
        if (n_in != 12 || in_sizes[0] != M * DM || out_size != M * DM || ws_size < WS_END) { fprintf(stderr, "kernel_launch: unexpected shapes: n_in %d in0 %d out %d ws %zu (need %zu)\n", n_in, n_in > 0 ? in_sizes[0] : -1, out_size, ws_size, (size_t)WS_END); grid = -1; return; }
        int dev = 0, cus = 0, per_cu = 0;
        if (hipGetDevice(&dev) != hipSuccess || hipDeviceGetAttribute(&cus, hipDeviceAttributeMultiprocessorCount, dev) != hipSuccess) { grid = -1; return; }
        if (hipFuncSetAttribute((const void*)fwd_megakernel, hipFuncAttributeMaxDynamicSharedMemorySize, LDS_BYTES) != hipSuccess) { fprintf(stderr, "kernel_launch: hipFuncSetAttribute failed\n"); grid = -1; return; }
        if (hipOccupancyMaxActiveBlocksPerMultiprocessor(&per_cu, (const void*)fwd_megakernel, NWAVES * 64, LDS_BYTES) != hipSuccess || per_cu < 1)
            fprintf(stderr, "kernel_launch: note: occupancy query reports %d workgroups per CU\n", per_cu);
        (void)hipGetLastError();
        grid = cus;
    }
    if (grid < 0) return;
    if (hipMemsetAsync((char*)d_ws + WS_CTL, 0, CTL_ZERO_BYTES, stream) != hipSuccess) { fprintf(stderr, "kernel_launch: hipMemsetAsync failed\n"); return; }
    Args a{};
    for (int i = 0; i < 12; ++i) a.in[i] = (const float*)d_in[i];
    a.out = (float*)d_out; a.ws = (unsigned char*)d_ws;
    hipLaunchKernelGGL(fwd_megakernel, dim3(grid), dim3(NWAVES * 64), LDS_BYTES, stream, a);
    const hipError_t le = hipPeekAtLastError();
    if (le != hipSuccess) fprintf(stderr, "kernel_launch: launch failed: %s\n", hipGetErrorName(le));
}
```

```cpp
#include <hip/hip_runtime.h>
#include <cstdio>
#include <cstdint>
namespace pg8 {
#define PG8_LAS __attribute__((address_space(3)))
typedef unsigned short bf16_t;
typedef short bf16x8 __attribute__((ext_vector_type(8)));
typedef float f32x4 __attribute__((ext_vector_type(4)));
typedef unsigned u32x4 __attribute__((ext_vector_type(4)));
constexpr int BM = 256, BK = 64, HALF = 128, HTB = HALF * BK * 2  , STAGE_BYTES = 8 * HTB, NXCD = 8, WGM = 8;

__host__ __device__ __forceinline__ int lds_byte(int r, int c) { const int st = (r >> 4) * 2 + (c >> 5), rr = r & 15, cc = c & 31, ob = rr * 64 + cc * 2; return st * 1024 + (ob ^ (((ob >> 9) & 1) << 5)); }
__host__ __device__ __forceinline__ void stage_rc(int b, int& R, int& C) { const int st = b / 1024, sb = b % 1024, swz = sb ^ (((sb >> 9) & 1) << 5); R = (st >> 1) * 16 + swz / 64; C = (st & 1) * 32 + (swz % 64) / 2; }
__host__ __device__ __forceinline__ int perm32(int rho) { const int n = rho >> 4, i = rho & 15; return 8 * (i >> 2) + 4 * n + (i & 3); }

struct Unit { int pm, pn; };
struct Gemm { const bf16_t* A; const bf16_t* Bt; int M, N, K; };

struct StaticOrder {
    int nM, nN, nwg, G, c;
    __host__ __device__ void init(int M, int N, int G_, int c_) { nM = M / BM; nN = N / BM; nwg = nM * nN; G = G_; c = c_; }
    __host__ __device__ bool next(int i, Unit& u) const {
        const long L = (long)i * G + c; if (L >= nwg) return false;
        int wgid = (int)L; { const int q = nwg / NXCD, r = nwg % NXCD, xcd = wgid % NXCD, off = wgid / NXCD; wgid = (xcd < r ? xcd * (q + 1) : r * (q + 1) + (xcd - r) * q) + off; }
        const int nig = WGM * nN, gid = wgid / nig, fm = gid * WGM, gsz = (nM - fm) < WGM ? (nM - fm) : WGM;
        u.pm = fm + ((wgid % nig) % gsz); u.pn = (wgid % nig) / gsz; return true;
    }
    __device__ __forceinline__ void a_ready(const Unit&) const {}
    __device__ __forceinline__ void done(const Unit&) const {}
};

__device__ __forceinline__ unsigned cvt_pk_bf16(float lo, float hi) { unsigned r; asm volatile("v_cvt_pk_bf16_f32 %0, %1, %2" : "=v"(r) : "v"(lo), "v"(hi)); return r; }
typedef float f32x2 __attribute__((ext_vector_type(2)));
__device__ __forceinline__ f32x2 gelu_pk(f32x2 v) {
    const f32x2 av = __builtin_elementwise_abs(v), d = av * 0.2316418882f + 1.0f;
    f32x2 t; t.x = __builtin_amdgcn_rcpf(d.x); t.y = __builtin_amdgcn_rcpf(d.y);
    f32x2 q = t * 0.5307027145f + (-0.7265760135f); q = q * t + 0.7107068705f; q = q * t + (-0.142248368f); q = q * t + 0.127414796f; q = q * t;
    const f32x2 s = (v * v) * (-0.72134752044f);
    f32x2 e; e.x = __builtin_amdgcn_exp2f(s.x); e.y = __builtin_amdgcn_exp2f(s.y);
    const f32x2 m = v * (q * e), r = v - m;
    f32x2 o; o.x = v.x < 0.f ? m.x : r.x; o.y = v.y < 0.f ? m.y : r.y; return o;
}

template <int ACT  > struct EpiBf16 {
    static constexpr bool PERM = true, AFTER_DRAIN = false; static_assert(ACT == 0 || ACT == 1, "EpiBf16: ACT is 0 (none) or 1 (gelu_pk)");
    bf16_t* O; int ldc; const float* bias; int split_cols; size_t split_stride; float scale0;
    __device__ __forceinline__ void operator()(const f32x4 (&acc)[2][2][4][2], const Unit& u, int wr, int wc, int fr, int fq) const {
        const int row0 = u.pm * BM + wr * 64 + fr; int colt = u.pn * BM; bf16_t* base = O;
        float sc = 1.f; if (split_cols) { const int t = colt / split_cols; base += (size_t)t * split_stride; colt -= t * split_cols; if (t == 0) sc = scale0; }
        const int col0 = colt + wc * 32 + 8 * fq, bcol0 = u.pn * BM + wc * 32 + 8 * fq;
        f32x4 bv[2][2];
#pragma unroll
        for (int bj = 0; bj < 2; ++bj)
#pragma unroll
            for (int n = 0; n < 2; ++n) bv[bj][n] = bias ? *(const f32x4*)(bias + bcol0 + bj * HALF + 4 * n) : (f32x4){0.f, 0.f, 0.f, 0.f};
#pragma unroll
        for (int ai = 0; ai < 2; ++ai)
#pragma unroll
            for (int m = 0; m < 4; ++m) { bf16_t* rowp = base + (size_t)(row0 + ai * HALF + m * 16) * ldc + col0;
#pragma unroll
                for (int bj = 0; bj < 2; ++bj) { f32x4 v0 = acc[ai][bj][m][0] + bv[bj][0], v1 = acc[ai][bj][m][1] + bv[bj][1];
                    if (ACT == 1) { f32x2 a = gelu_pk((f32x2){v0[0], v0[1]}), b = gelu_pk((f32x2){v0[2], v0[3]}), c = gelu_pk((f32x2){v1[0], v1[1]}), d = gelu_pk((f32x2){v1[2], v1[3]});
                        v0 = (f32x4){a.x, a.y, b.x, b.y}; v1 = (f32x4){c.x, c.y, d.x, d.y}; }
                    v0 = v0 * sc; v1 = v1 * sc; u32x4 w; w.x = cvt_pk_bf16(v0[0], v0[1]); w.y = cvt_pk_bf16(v0[2], v0[3]); w.z = cvt_pk_bf16(v1[0], v1[1]); w.w = cvt_pk_bf16(v1[2], v1[3]);
                    *(u32x4*)(rowp + bj * HALF) = w; } }
    }
};
__device__ __forceinline__ int epi_col0(const Unit& u, int wc, int fq) { return u.pn * BM + 64 * wc + 8 * fq; }
struct EpiB16 {
    static constexpr bool PERM = true, AFTER_DRAIN = false;
    bf16_t* O; int ldc; const float* rs;
    __device__ __forceinline__ void operator()(const f32x4 (&acc)[2][2][4][2], const Unit& u, int wr, int wc, int fr, int fq) const {
        const int row0 = u.pm * BM + wr * 64 + fr; const int col0 = epi_col0(u, wc, fq);
#pragma unroll
        for (int ai = 0; ai < 2; ++ai)
#pragma unroll
            for (int m = 0; m < 4; ++m) { const int row = row0 + ai * HALF + m * 16; const float sc = rs ? rs[row] : 1.0f; bf16_t* rowp = O + (size_t)row * ldc + col0;
#pragma unroll
                for (int bj = 0; bj < 2; ++bj) { const f32x4 v0 = acc[ai][bj][m][0] * sc, v1 = acc[ai][bj][m][1] * sc;
                    u32x4 w; w.x = cvt_pk_bf16(v0[0], v0[1]); w.y = cvt_pk_bf16(v0[2], v0[3]); w.z = cvt_pk_bf16(v1[0], v1[1]); w.w = cvt_pk_bf16(v1[2], v1[3]);
                    *(u32x4*)(rowp + 32 * bj) = w; } }
    }
};
struct EpiFinal {
    static constexpr bool PERM = true, AFTER_DRAIN = false;
    const bf16_t* H; float* O; const bf16_t* P; const float* bg; int ldc;
    __device__ __forceinline__ void operator()(const f32x4 (&acc)[2][2][4][2], const Unit& u, int wr, int wc, int fr, int fq) const {
        const int row0 = u.pm * BM + wr * 64 + fr, col0 = epi_col0(u, wc, fq);
        f32x4 bv[2][2];
#pragma unroll
        for (int bj = 0; bj < 2; ++bj)
#pragma unroll
            for (int n = 0; n < 2; ++n) bv[bj][n] = *(const f32x4*)(bg + col0 + 32 * bj + 4 * n);
#pragma unroll
        for (int ai = 0; ai < 2; ++ai)
#pragma unroll
            for (int m = 0; m < 4; ++m) { const size_t off = (size_t)(row0 + ai * HALF + m * 16) * ldc + col0;
#pragma unroll
                for (int bj = 0; bj < 2; ++bj) { const size_t o2 = off + 32 * bj;
                    const u32x4 hw = *(const u32x4*)(H + o2), pw = *(const u32x4*)(P + o2);
                    const unsigned hws[4] = {hw.x, hw.y, hw.z, hw.w}, pws[4] = {pw.x, pw.y, pw.z, pw.w};
#pragma unroll
                    for (int n = 0; n < 2; ++n) { const f32x4 a = acc[ai][bj][m][n] + bv[bj][n]; f32x4 o;
                        o[0] = __uint_as_float(hws[2 * n] << 16) + __uint_as_float(pws[2 * n] << 16) / (1.0f + __expf(-a[0]));
                        o[1] = __uint_as_float(hws[2 * n] & 0xffff0000u) + __uint_as_float(pws[2 * n] & 0xffff0000u) / (1.0f + __expf(-a[1]));
                        o[2] = __uint_as_float(hws[2 * n + 1] << 16) + __uint_as_float(pws[2 * n + 1] << 16) / (1.0f + __expf(-a[2]));
                        o[3] = __uint_as_float(hws[2 * n + 1] & 0xffff0000u) + __uint_as_float(pws[2 * n + 1] & 0xffff0000u) / (1.0f + __expf(-a[3]));
                        *(f32x4*)(O + o2 + 4 * n) = o; } }
                if (m & 1) asm volatile("" ::: "memory"); }
    }
};
template <class Epi, class Sched, bool ALIGN_EPI = false, bool SP2 = false>
__device__ __forceinline__ void gemm_phase(PG8_LAS unsigned char* lds, const Gemm g, const Sched& S, const Epi& E, const int wave_in  ) {
    int lane_; asm volatile("v_mbcnt_lo_u32_b32 %0, -1, 0\n\tv_mbcnt_hi_u32_b32 %0, -1, %0" : "=v"(lane_));
    const int wid = wave_in, lane = lane_, tid = wid * 64 + lane, wr = wid >> 2, wc = wid & 3, fr = lane & 15, fq = lane >> 4;
    const int K = g.K, nt = K / BK;
    unsigned voffA[2], voffB[2];
#pragma unroll
    for (int i = 0; i < 2; ++i) { int R, C; stage_rc(tid * 16 + i * 8192, R, C); const int Rb = Epi::PERM ? ((R & ~31) + perm32(R & 31)) : R;
        voffA[i] = (unsigned)(R * K + C) * 2u; voffB[i] = (unsigned)(Rb * K + C) * 2u; }
    const size_t kstep = (size_t)(BK * 2);
    const size_t hstep = (size_t)HALF * K * 2;
    const size_t tstep = 2 * hstep;
    const unsigned ldsw = (unsigned)wid * 1024u;
    const int aoff = lds_byte(wr * 64 + fr, fq * 8), boff = lds_byte(wc * 32 + fr, fq * 8);
#define PG8_SA(b, h) (((b) * 2 + (h)) * HTB)
#define PG8_SB(b, h) ((4 + (b) * 2 + (h)) * HTB)
#define PG8_STAGE(bufoff, gbase, voff) do { _Pragma("unroll") for (int _i = 0; _i < 2; ++_i) \
        __builtin_amdgcn_global_load_lds((const unsigned*)((const char*)(gbase) + (voff)[_i]), (PG8_LAS unsigned*)(lds + (bufoff) + ldsw + _i * 8192), 16, 0, 0); } while (0)
#define PG8_LDA(dst, b, h) do { _Pragma("unroll") for (int m = 0; m < 4; ++m) _Pragma("unroll") for (int k = 0; k < 2; ++k) dst[m][k] = *(const PG8_LAS bf16x8*)(lds + PG8_SA(b, h) + aoff + m * 2048 + k * 1024); } while (0)
#define PG8_LDB(dst, b, h) do { _Pragma("unroll") for (int n = 0; n < 2; ++n) _Pragma("unroll") for (int k = 0; k < 2; ++k) dst[n][k] = *(const PG8_LAS bf16x8*)(lds + PG8_SB(b, h) + boff + n * 2048 + k * 1024); } while (0)
#define PG8_MMA(ai, bj, At, Bt) do { __builtin_amdgcn_s_setprio(1); _Pragma("unroll") for (int m = 0; m < 4; ++m) _Pragma("unroll") for (int n = 0; n < 2; ++n) _Pragma("unroll") for (int k = 0; k < 2; ++k) \
        acc[ai][bj][m][n] = __builtin_amdgcn_mfma_f32_16x16x32_bf16(Bt[n][k], At[m][k], acc[ai][bj][m][n], 0, 0, 0); __builtin_amdgcn_s_setprio(0); } while (0)
#define PG8_WAIT_V(n) asm volatile("s_waitcnt vmcnt(" #n ")" ::: "memory")
#define PG8_WAIT_L(n) asm volatile("s_waitcnt lgkmcnt(" #n ")" ::: "memory")
#define PG8_BAR __builtin_amdgcn_s_barrier()
#define PG8_SCHED __builtin_amdgcn_sched_barrier(0)
    Unit cur, nxt; int ui = 0;
    if (!S.next(0, cur)) return;
    f32x4 acc[2][2][4][2];
#pragma unroll
    for (int a = 0; a < 2; ++a)
#pragma unroll
        for (int b = 0; b < 2; ++b)
#pragma unroll
            for (int m = 0; m < 4; ++m)
#pragma unroll
                for (int n = 0; n < 2; ++n) acc[a][b][m][n] = (f32x4){0.f, 0.f, 0.f, 0.f};
    bf16x8 At[4][2], B0[2][2], B1[2][2];
    const char* cA = (const char*)g.A + (size_t)cur.pm * tstep; const char* cB = (const char*)g.Bt + (size_t)cur.pn * tstep;
    S.a_ready(cur);
    if constexpr (SP2) {
        PG8_STAGE(PG8_SB(0, 0), cB, voffB); PG8_STAGE(PG8_SB(0, 1), cB + hstep, voffB); PG8_STAGE(PG8_SA(0, 0), cA, voffA); PG8_STAGE(PG8_SA(0, 1), cA + hstep, voffA);
        if (wr == 1) PG8_BAR;
        PG8_WAIT_V(2); PG8_BAR;
        PG8_STAGE(PG8_SB(1, 0), cB + kstep, voffB); PG8_STAGE(PG8_SA(1, 0), cA + kstep, voffA); PG8_STAGE(PG8_SB(1, 1), cB + hstep + kstep, voffB);
        PG8_WAIT_V(6); PG8_BAR;
    } else {
        PG8_STAGE(PG8_SB(0, 0), cB, voffB); PG8_STAGE(PG8_SA(0, 0), cA, voffA); PG8_STAGE(PG8_SB(0, 1), cB + hstep, voffB); PG8_STAGE(PG8_SA(0, 1), cA + hstep, voffA);
        if (wr == 1) PG8_BAR;
        PG8_WAIT_V(4); PG8_BAR;
        PG8_STAGE(PG8_SB(1, 0), cB + kstep, voffB); PG8_STAGE(PG8_SA(1, 0), cA + kstep, voffA); PG8_STAGE(PG8_SB(1, 1), cB + hstep + kstep, voffB);
        PG8_WAIT_V(6); PG8_BAR;
    }
    for (;;) {
        const bool has_next = S.next(ui + 1, nxt);
        const char* nA = has_next ? (const char*)g.A + (size_t)nxt.pm * tstep : cA; const char* nB = has_next ? (const char*)g.Bt + (size_t)nxt.pn * tstep : cB;
        for (int t = 0; t < nt; t += 2) {
            const bool last = (t == nt - 2);
            const char* a1 = cA + (size_t)(t + 1) * kstep;
            const char* a2 = last ? nA : cA + (size_t)(t + 2) * kstep; const char* b2 = last ? nB : cB + (size_t)(t + 2) * kstep;
            const char* a3 = a2 + kstep; const char* b3 = b2 + kstep;
            if (last && has_next) S.a_ready(nxt);
            if constexpr (SP2) {
            PG8_LDB(B0, 0, 0); PG8_LDB(B1, 0, 1); PG8_SCHED; PG8_LDA(At, 0, 0); PG8_STAGE(PG8_SA(1, 1), a1 + hstep, voffA);
            PG8_WAIT_V(8); PG8_WAIT_L(0); PG8_BAR; PG8_MMA(0, 0, At, B0); PG8_MMA(0, 1, At, B1); PG8_BAR; PG8_SCHED;
            PG8_LDA(At, 0, 1); PG8_STAGE(PG8_SB(0, 0), b2, voffB); PG8_STAGE(PG8_SB(0, 1), b2 + hstep, voffB); PG8_STAGE(PG8_SA(0, 0), a2, voffA);
            PG8_WAIT_V(8); PG8_WAIT_L(0); PG8_BAR; PG8_MMA(1, 0, At, B0); PG8_MMA(1, 1, At, B1); PG8_BAR; PG8_SCHED;
            PG8_LDB(B0, 1, 0); PG8_LDB(B1, 1, 1); PG8_SCHED; PG8_LDA(At, 1, 0); PG8_STAGE(PG8_SA(0, 1), a2 + hstep, voffA);
            PG8_WAIT_V(8); PG8_WAIT_L(0); PG8_BAR; PG8_MMA(0, 0, At, B0); PG8_MMA(0, 1, At, B1); PG8_BAR; PG8_SCHED;
            PG8_LDA(At, 1, 1); PG8_STAGE(PG8_SB(1, 0), b3, voffB); PG8_STAGE(PG8_SB(1, 1), b3 + hstep, voffB); PG8_STAGE(PG8_SA(1, 0), a3, voffA);
            PG8_WAIT_V(8); PG8_WAIT_L(0); PG8_BAR; PG8_MMA(1, 0, At, B0); PG8_MMA(1, 1, At, B1); PG8_BAR; PG8_SCHED;
            } else {
            PG8_LDB(B0, 0, 0); PG8_SCHED; PG8_LDA(At, 0, 0); PG8_STAGE(PG8_SA(1, 1), a1 + hstep, voffA);
            PG8_WAIT_L(8); PG8_BAR; PG8_WAIT_L(0); PG8_MMA(0, 0, At, B0); PG8_BAR; PG8_SCHED;
            PG8_LDB(B1, 0, 1); PG8_STAGE(PG8_SB(0, 0), b2, voffB);
            PG8_BAR; PG8_WAIT_L(0); PG8_MMA(0, 1, At, B1); PG8_BAR;
            PG8_LDA(At, 0, 1); PG8_STAGE(PG8_SA(0, 0), a2, voffA);
            PG8_BAR; PG8_WAIT_L(0); PG8_MMA(1, 0, At, B0); PG8_BAR; PG8_SCHED;
            PG8_STAGE(PG8_SB(0, 1), b2 + hstep, voffB);
            PG8_WAIT_V(6); PG8_BAR; PG8_MMA(1, 1, At, B1); PG8_BAR;
            PG8_LDB(B0, 1, 0); PG8_SCHED; PG8_LDA(At, 1, 0); PG8_STAGE(PG8_SA(0, 1), a2 + hstep, voffA);
            PG8_WAIT_L(8); PG8_BAR; PG8_WAIT_L(0); PG8_MMA(0, 0, At, B0); PG8_BAR; PG8_SCHED;
            PG8_LDB(B1, 1, 1); PG8_STAGE(PG8_SB(1, 0), b3, voffB);
            PG8_BAR; PG8_WAIT_L(0); PG8_MMA(0, 1, At, B1); PG8_BAR;
            PG8_LDA(At, 1, 1); PG8_STAGE(PG8_SA(1, 0), a3, voffA);
            PG8_BAR; PG8_WAIT_L(0); PG8_MMA(1, 0, At, B0); PG8_BAR; PG8_SCHED;
            PG8_STAGE(PG8_SB(1, 1), b3 + hstep, voffB);
            PG8_WAIT_V(6); PG8_BAR; PG8_MMA(1, 1, At, B1); PG8_BAR;
            }
        }
        if constexpr (ALIGN_EPI) { if (wr == 0) PG8_BAR; }
        if constexpr (!Epi::AFTER_DRAIN) { E(acc, cur, wr, wc, fr, fq); S.done(cur); }
        if (!has_next) break;
#pragma unroll
        for (int a = 0; a < 2; ++a)
#pragma unroll
            for (int b = 0; b < 2; ++b)
#pragma unroll
                for (int m = 0; m < 4; ++m)
#pragma unroll
                    for (int n = 0; n < 2; ++n) acc[a][b][m][n] = (f32x4){0.f, 0.f, 0.f, 0.f};
        cur = nxt; cA = nA; cB = nB; ++ui;
        if constexpr (ALIGN_EPI) { if (wr == 1) PG8_BAR; }
    }
    PG8_WAIT_V(0);
    if constexpr (!ALIGN_EPI) { if (wr == 0) PG8_BAR; }
    PG8_BAR;
    if constexpr (Epi::AFTER_DRAIN) { E.fused(acc, cur, wr, wc, fr, fq, lds, wid, lane); S.done(cur); }
#undef PG8_SA
#undef PG8_SB
#undef PG8_STAGE
#undef PG8_LDA
#undef PG8_LDB
#undef PG8_MMA
#undef PG8_WAIT_V
#undef PG8_WAIT_L
#undef PG8_BAR
#undef PG8_SCHED
}
}
#define GAS __attribute__((address_space(1)))
#define LAS __attribute__((address_space(3)))
typedef unsigned short bf16;
typedef unsigned v4u __attribute__((ext_vector_type(4)));
typedef float f32x4 __attribute__((ext_vector_type(4)));
typedef short bf16x8 __attribute__((ext_vector_type(8)));
typedef GAS unsigned gu32;
typedef GAS unsigned long long gu64;
#define RLX_AGENT __ATOMIC_RELAXED, __HIP_MEMORY_SCOPE_AGENT
#define LDS_WAIT() asm volatile("s_waitcnt lgkmcnt(0)" ::: "memory")
#define VM_WAIT() asm volatile("s_waitcnt vmcnt(0)" ::: "memory")
__device__ __forceinline__ unsigned long long rt() { return __builtin_amdgcn_s_memrealtime(); }
__device__ __forceinline__ unsigned f2bf(float f) { unsigned u = __builtin_bit_cast(unsigned, f); return (u + 0x7fffu + ((u >> 16) & 1u)) >> 16; }
__device__ __forceinline__ unsigned pk2(float lo, float hi) { return f2bf(lo) | (f2bf(hi) << 16); }

#define XB_TMO      128
#define XB_XCNT(j)  (256  + 64 * (j))
#define XB_XSUB(j)  (1280 + 64 * (j))
#define XB_XGEN(j)  (2304 + 64 * (j))
#define XB_TOP      3328
#define XB_TOPGEN   3392
#define XCD_BAR_WORDS 3456
#define XB_SPIN_CAP (1u << 18)

__device__ __forceinline__ unsigned xb_ld(unsigned* p)              { return __hip_atomic_load(p, __ATOMIC_RELAXED, __HIP_MEMORY_SCOPE_AGENT); }
__device__ __forceinline__ unsigned xb_add(unsigned* p, unsigned v) { return __hip_atomic_fetch_add(p, v, __ATOMIC_RELAXED, __HIP_MEMORY_SCOPE_AGENT); }
__device__ __forceinline__ unsigned xb_xcc_id() { return (unsigned)__builtin_amdgcn_s_getreg((3 << 11) | 20) & 0xFu; }
#define XB_SPIN(cond, bar) do { unsigned _sp = 0; while (cond) { __builtin_amdgcn_s_sleep(1); \
    if ((++_sp & 255u) == 0u) { if (xb_ld(&(bar)[XB_TMO])) break; if (_sp > XB_SPIN_CAP) { atomicAdd(&(bar)[XB_TMO], 1u); break; } } } } while (0)

struct XcdBarrier {
    unsigned* bar; unsigned x; unsigned w;
    volatile LAS unsigned* st;
};

__device__ __forceinline__ XcdBarrier xcd_barrier_post(unsigned* bar, volatile LAS unsigned* st) {
    XcdBarrier b; b.bar = bar; b.x = xb_xcc_id(); b.st = st; b.w = (unsigned)__builtin_amdgcn_readfirstlane(threadIdx.x >> 6);
    if (threadIdx.x == 0) (void)xb_add(&bar[XB_XCNT(b.x)], 1u);
    return b;
}
__device__ __forceinline__ void xcd_barrier_complete(unsigned* bar, unsigned x, unsigned& nloc, unsigned& nx) {
    const unsigned G = gridDim.x * gridDim.y * gridDim.z;
    unsigned sum, cnt, mine, sp = 0u;
    for (;;) {
        sum = 0u; cnt = 0u; mine = 0u;
#pragma unroll
        for (unsigned j = 0; j < 16; ++j) { const unsigned c = xb_ld(&bar[XB_XCNT(j)]); sum += c; cnt += (c > 0u) ? 1u : 0u; mine = (j == x) ? c : mine; }
        if (sum == G) break;
        __builtin_amdgcn_s_sleep(1);
        if ((++sp & 255u) == 0u) { if (xb_ld(&bar[XB_TMO])) break; if (sp > XB_SPIN_CAP) { atomicAdd(&bar[XB_TMO], 1u); break; } }
    }
    nloc = mine > 0u ? mine : 1u; nx = cnt > 0u ? cnt : 1u;
}

__device__ __forceinline__ void xcd_barrier(const XcdBarrier& b) {
    asm volatile("s_waitcnt vmcnt(0)" ::: "memory");
    __syncthreads();
    unsigned lane_b; asm volatile("v_mbcnt_lo_u32_b32 %0, -1, 0\n\tv_mbcnt_hi_u32_b32 %0, -1, %0" : "=v"(lane_b));
    if (b.w == 0u && lane_b == 0u) {
        unsigned* bar = b.bar;
        __builtin_amdgcn_s_waitcnt(0);
        unsigned nloc = b.st[0], nx = b.st[1];
        if (nloc == 0u) { xcd_barrier_complete(bar, b.x, nloc, nx); b.st[0] = nloc; b.st[1] = nx; }
        const unsigned old = xb_add(&bar[XB_XSUB(b.x)], 1u);
        const unsigned gen = old / nloc;
        if (old + 1u == (gen + 1u) * nloc) {
            __builtin_amdgcn_fence(__ATOMIC_RELEASE, "agent");
            asm volatile("s_waitcnt vmcnt(0)" ::: "memory");
            const unsigned og = xb_add(&bar[XB_TOP], 1u);
            const unsigned tg = og / nx;
            if (og + 1u == (tg + 1u) * nx) xb_add(&bar[XB_TOPGEN], 1u);
            else XB_SPIN(xb_ld(&bar[XB_TOPGEN]) == tg, bar);
            __builtin_amdgcn_fence(__ATOMIC_ACQUIRE, "agent");
            xb_add(&bar[XB_XGEN(b.x)], 1u);
            asm volatile("s_waitcnt vmcnt(0)" ::: "memory");
        } else {
            XB_SPIN(xb_ld(&bar[XB_XGEN(b.x)]) == gen, bar);
            __builtin_amdgcn_fence(__ATOMIC_ACQUIRE, "agent");
            asm volatile("s_waitcnt vmcnt(0)" ::: "memory");
        }
    }
    __syncthreads();
}
#ifndef REP3A
#define REP3A 1
#endif
#ifndef REP2B
#define REP2B 1
#endif
#ifndef REP2A
#define REP2A 1
#endif
#ifndef REP6
#define REP6 1
#endif
#ifndef REP5
#define REP5 1
#endif
#ifndef REP0A
#define REP0A 1
#endif
#ifndef REP0B
#define REP0B 1
#endif
#ifndef REP0
#define REP0 1
#endif
#ifndef REP1
#define REP1 1
#endif
#ifndef REP2
#define REP2 1
#endif
#ifndef REP3
#define REP3 1
#endif
#ifndef REP4
#define REP4 1
#endif
constexpr int NWAVES = 8;
constexpr int BATCH = 4, SEQ = 4096, DM = 2048, M = BATCH * SEQ;
constexpr int PLE = 256;
constexpr int GH = 4, GDK = 128, GDV = 256, GRANK = 16;
constexpr int SH = 8, SDH = 128;
constexpr int DIN_SRC = 7184;
constexpr int LDU = 7168;
constexpr int UQ = 0, UK = 512, UV = 1024, UG = 2048, USQ = 3072, USK = 4096, USV = 5120, USG = 6144;
constexpr float EPS = 1e-6f;
constexpr float SB_T = 30.0f;

constexpr size_t MiB = 1u << 20;
constexpr size_t WS_CTL = 0, CTL_ZERO_BYTES = 1 * MiB;
constexpr size_t WS_WIN = 2 * MiB, WS_WOUT = 30 * MiB, WS_WG = 38 * MiB, WS_WP = 46 * MiB;
constexpr size_t WS_RS = 47 * MiB, WS_GLR = 48 * MiB, WS_PIN = 50 * MiB;
constexpr size_t WS_BDEC = 64 * MiB;
constexpr size_t WS_XB = 64 * MiB;
constexpr size_t WS_U = 128 * MiB;
constexpr size_t WS_PB = 128 * MiB;
constexpr size_t WS_MIX = 192 * MiB;
constexpr size_t WS_HRES = 352 * MiB;
constexpr size_t WS_MIXIN = 352 * MiB;
constexpr size_t WS_DS = 416 * MiB, WS_SIN = 448 * MiB, WS_GS = 480 * MiB;
constexpr size_t WS_END = 481 * MiB;
constexpr int CW_BAR = 4096;

constexpr int RING_OFF = 0, RING_BYTES = 131072;
constexpr int LDSCTL_OFF = 152064, MISC_OFF = LDSCTL_OFF + 320;
constexpr int LDS_BYTES = 153600;
constexpr int P0_TAB_OFF = 69632, P0_PART_OFF = 135168;

struct Frame {
    LAS unsigned char* lds;
    volatile LAS unsigned* MISC;
    gu32* ctl;
    int vcu, G, wave;
};
#define F_WAVE F.wave
#define PHASE_IDS() int lane_o; asm volatile("v_mbcnt_lo_u32_b32 %0, -1, 0\n\tv_mbcnt_hi_u32_b32 %0, -1, %0" : "=v"(lane_o)); \
    const int lane = lane_o, wave = F_WAVE, tid = wave * 64 + lane; (void)tid; (void)lane; (void)wave
__device__ __forceinline__ float wave_sum(float v) {
#pragma unroll
    for (int o = 1; o < 64; o <<= 1) v += __shfl_xor(v, o);
    return v;
}
__device__ __forceinline__ float bf_lo(unsigned w) { return __uint_as_float(w << 16); }
__device__ __forceinline__ float bf_hi(unsigned w) { return __uint_as_float(w & 0xffff0000u); }
__device__ __forceinline__ float bf2f(bf16 b) { return __uint_as_float(((unsigned)b) << 16); }

__device__ __forceinline__ void p0_item64(const float* W, int ldw, int K, bf16* WT, int src_col0, int dst_col0, int k0, const float* gk, LAS float* scr, int lane) {
#pragma unroll 8
    for (int i = 0; i < 16; ++i) { const int kk = 4 * i + (lane >> 4), c4 = 4 * (lane & 15);
        f32x4 v = *(const GAS f32x4*)(W + (size_t)(k0 + kk) * ldw + src_col0 + c4); if (gk) { const float g = gk[k0 + kk]; v = v * g; }
        LAS float* d = scr + kk * 65 + c4; d[0] = v.x; d[1] = v.y; d[2] = v.z; d[3] = v.w; }
    LDS_WAIT(); asm volatile("" ::: "memory");
    const int c = lane & 7, tile0 = dst_col0 & ~255, wc = (dst_col0 >> 6) & 3;
#pragma unroll
    for (int j = 0; j < 8; ++j) { const int r64 = 8 * j + (lane >> 3), bj = r64 >> 5, rho = r64 & 31, csrc = r64;
        const LAS float* s = scr + (8 * c) * 65 + csrc;
        v4u o; o.x = pk2(s[0 * 65], s[1 * 65]); o.y = pk2(s[2 * 65], s[3 * 65]); o.z = pk2(s[4 * 65], s[5 * 65]); o.w = pk2(s[6 * 65], s[7 * 65]);
        *(GAS v4u*)(WT + (size_t)(tile0 + 128 * bj + 32 * wc + rho) * K + k0 + 8 * c) = o; }
    LDS_WAIT(); asm volatile("" ::: "memory");
}

struct Args { const float* in[12]; float* out; unsigned char* ws; };
typedef short v4i16_t __attribute__((ext_vector_type(4)));
namespace gla {
typedef short s16x4 __attribute__((ext_vector_type(4)));
typedef float f32x16 __attribute__((ext_vector_type(16)));
typedef float f32x2_t __attribute__((ext_vector_type(2)));
typedef __bf16 bf16x2_t __attribute__((ext_vector_type(2)));
constexpr int L_Q = 0, L_K = 16384, L_L = 32768, L_V = 49152, L_O = 81920, L_TOT = 147456, L_GC = 151552, L_END = 152064;
constexpr float L2E = 1.4426950408889634f;
__device__ __forceinline__ unsigned off_b(unsigned row, unsigned ch) { return 256u * row + 16u * (ch ^ (((row & 3u) << 2) | ((row >> 2) & 3u))); }
__device__ __forceinline__ int crow(int i, int hh) { return (i & 3) + 8 * (i >> 2) + 4 * hh; }
__device__ __forceinline__ unsigned cvtpk(float lo, float hi) { f32x2_t v = {lo, hi}; bf16x2_t b = __builtin_convertvector(v, bf16x2_t); return __builtin_bit_cast(unsigned, b); }
__device__ __forceinline__ s16x4 vtr(LAS const unsigned char* p) { return __builtin_bit_cast(s16x4, __builtin_amdgcn_ds_read_tr16_b64_v4i16((LAS v4i16_t*)p)); }
__device__ __forceinline__ bf16x8 tr_frag(LAS const unsigned char* img, int lane, int c, int ks) {
    const unsigned hh = lane >> 5, blk = (lane >> 4) & 1, q = (lane & 15) >> 2, p = lane & 3;
    const unsigned ch = 4u * c + 2u * blk + (p >> 1);
    const unsigned r0 = 16u * ks + 4u * hh + q, r1 = r0 + 8u;
    const s16x4 lo = vtr(img + off_b(r0, ch) + 8u * (p & 1)), hi = vtr(img + off_b(r1, ch) + 8u * (p & 1));
    return __builtin_shufflevector(lo, hi, 0, 1, 2, 3, 4, 5, 6, 7);
}
__device__ __forceinline__ bf16x8 row_frag(LAS const unsigned char* img, int row, int s, int hh) { return *(const LAS bf16x8*)(img + off_b(row, 2 * s + hh)); }
__device__ __forceinline__ bf16x8 pack8(const f32x16& x, int s) {
    v4u p; p.x = cvtpk(x[8 * s + 0], x[8 * s + 1]); p.y = cvtpk(x[8 * s + 2], x[8 * s + 3]); p.z = cvtpk(x[8 * s + 4], x[8 * s + 5]); p.w = cvtpk(x[8 * s + 6], x[8 * s + 7]);
    return __builtin_bit_cast(bf16x8, p);
}
#define GLA_MFMA(a, b, c) __builtin_amdgcn_mfma_f32_32x32x16_bf16((a), (b), (c), 0, 0, 0)
#define GLA_BAR() asm volatile("s_waitcnt lgkmcnt(0)\n\ts_barrier" ::: "memory")

template <int PASS  >
__device__ __forceinline__ void item(Frame& F, const Args& A, int it) {
    PHASE_IDS();
    LAS unsigned char* lds = F.lds;
    const float* w_a2 = A.in[4]; const float* b_a = A.in[5]; const float* g_head = A.in[6];
    const bf16* U = (const bf16*)(A.ws + WS_U); const float* GLR = (const float*)(A.ws + WS_GLR); bf16* MIXIN = (bf16*)(A.ws + WS_MIXIN);
    float* BDEC = (float*)(A.ws + WS_BDEC);
    float* DS = (float*)(A.ws + WS_DS); float* SIN = (float*)(A.ws + WS_SIN); float* GS = (float*)(A.ws + WS_GS);
    const int sc = it & 15, h = (it >> 4) & 3, b = it >> 6;
    const int hh0 = lane >> 5, r320 = lane & 31; int lane_s = lane;
    LAS unsigned char* imgQ = lds + L_Q; LAS unsigned char* imgK = lds + L_K; LAS unsigned char* imgL = lds + L_L; LAS unsigned char* imgV = lds + L_V;
    LAS float* Ot = (LAS float*)(lds + L_O); LAS float* tot = (LAS float*)(lds + L_TOT); LAS float* gc = (LAS float*)(lds + L_GC);
    f32x16 St[4];
#pragma unroll
    for (int db = 0; db < 4; ++db)
#pragma unroll
        for (int i = 0; i < 16; ++i) St[db][i] = PASS ? SIN[(size_t)it * 32768 + (size_t)(32 * db + crow(i, hh0)) * 256 + 32 * wave + r320] : 0.f;
    float blsum[2] = {0.f, 0.f};
    float g0, g1; unsigned kv[8], qv[8]; unsigned long long gpre[8]; f32x2_t bd[8], ball;
#define GLA_LOAD_QK(mm) do { const size_t mq_ = (mm); if (!PASS) { g0 = GLR[(mq_ + 8 * wave) * 16 + lane]; g1 = GLR[(mq_ + 8 * wave) * 16 + 64 + lane]; }     \
        _Pragma("unroll") for (int i = 0; i < 8; ++i) { kv[i] = *(const GAS unsigned*)(U + (mq_ + 8 * wave + i) * LDU + UK + h * 128 + 2 * lane); \
            if (PASS) qv[i] = *(const GAS unsigned*)(U + (mq_ + 8 * wave + i) * LDU + UQ + h * 128 + 2 * lane); } } while (0)
#define GLA_LOAD_B(mm) do { const size_t mb_ = (mm); ball = *(const GAS f32x2_t*)(BDEC + (mb_ + 63) * 512 + h * 128 + 2 * lane); \
        _Pragma("unroll") for (int i = 0; i < 8; ++i) bd[i] = *(const GAS f32x2_t*)(BDEC + (mb_ + 8 * wave + i) * 512 + h * 128 + 2 * lane); } while (0)
#define GLA_LOAD_V(mm) do { const size_t mv_ = (mm); _Pragma("unroll") for (int j = 0; j < 4; ++j) { const int pidx = 4 * wave + j, eh = pidx >> 4, rg = pidx & 15; \
            const unsigned row = 4u * rg + ((unsigned)lane >> 4), ch = ((unsigned)lane & 15u) ^ (((row & 3u) << 2) | ((row >> 2) & 3u)); \
            __builtin_amdgcn_global_load_lds((const GAS unsigned*)(U + (mv_ + row) * LDU + UV + h * 256 + eh * 128 + 8 * ch), (LAS unsigned*)(imgV + eh * 16384 + 1024 * rg), 16, 0, 0); } } while (0)
    { const size_t mf = (size_t)b * SEQ + sc * 256; GLA_LOAD_QK(mf); GLA_LOAD_V(mf); if (PASS) GLA_LOAD_B(mf); }
    for (int c4 = 0; c4 < 4; ++c4) {
        const size_t m0 = (size_t)b * SEQ + sc * 256 + c4 * 64;
        { int l1 = lane_o; asm volatile("" : "+v"(l1)); lane_s = l1; }
#define lane lane_s
#define tid (wave * 64 + lane_s)
        const unsigned d0 = 2u * lane, pq = (d0 & ~12u) | ((d0 & 4u) << 1) | ((d0 & 8u) >> 1);
        float cs[8][2]; float pref[2] = {0.f, 0.f}, all[2] = {0.f, 0.f};
        if (!PASS) {
        const GAS float* w_a2o = (const GAS float*)w_a2; asm volatile("" : "+s"(w_a2o));
        float wa[2][16], ba[2];
#pragma unroll
        for (int c = 0; c < 2; ++c) { ba[c] = b_a[h * 128 + 2 * lane + c];
#pragma unroll
            for (int r = 0; r < 16; ++r) wa[c][r] = w_a2o[r * 512 + h * 128 + 2 * lane + c]; }
#pragma unroll
        for (int i = 0; i < 8; ++i) {
            float pre0 = ba[0], pre1 = ba[1];
#pragma unroll
            for (int r = 0; r < 16; ++r) { const float g = __uint_as_float((unsigned)__builtin_amdgcn_readlane((int)__float_as_uint(i < 4 ? g0 : g1), (i & 3) * 16 + r)); pre0 += g * wa[0][r]; pre1 += g * wa[1][r]; }
            const float l0 = (fminf(pre0, 0.f) * L2E - __builtin_amdgcn_logf(1.0f + __builtin_amdgcn_exp2f(-fabsf(pre0) * L2E))) * (1.0f / 16.0f);
            const float l1 = (fminf(pre1, 0.f) * L2E - __builtin_amdgcn_logf(1.0f + __builtin_amdgcn_exp2f(-fabsf(pre1) * L2E))) * (1.0f / 16.0f);
            cs[i][0] = (i ? cs[i - 1][0] : 0.f) + l0; cs[i][1] = (i ? cs[i - 1][1] : 0.f) + l1;
        }
        *(LAS f32x2_t*)(tot + wave * 128 + 2 * lane) = (f32x2_t){cs[7][0], cs[7][1]};
        GLA_BAR();
#pragma unroll
        for (int w2 = 0; w2 < 8; ++w2) { const f32x2_t tv = *(const LAS f32x2_t*)(tot + w2 * 128 + 2 * lane); all[0] += tv.x; all[1] += tv.y; if (w2 < wave) { pref[0] += tv.x; pref[1] += tv.y; } }
#pragma unroll
        for (int i = 0; i < 8; ++i) *(GAS f32x2_t*)(BDEC + (m0 + 8 * wave + i) * 512 + h * 128 + 2 * lane) = (f32x2_t){pref[0] + cs[i][0], pref[1] + cs[i][1]};
        } else {
#pragma unroll
            for (int i = 0; i < 8; ++i) { cs[i][0] = bd[i].x; cs[i][1] = bd[i].y; }
            all[0] = ball.x; all[1] = ball.y;
        }
        const float gl0 = __builtin_amdgcn_exp2f(all[0]), gl1 = __builtin_amdgcn_exp2f(all[1]);
        blsum[0] += all[0]; blsum[1] += all[1];
        if (wave == 0) *(LAS f32x2_t*)(gc + 2 * lane) = (f32x2_t){gl0, gl1};
#pragma unroll
        for (int i = 0; i < 8; ++i) {
            const int t = 8 * wave + i;
            const float b0 = pref[0] + cs[i][0], b1 = pref[1] + cs[i][1];
            const float en0 = __builtin_amdgcn_exp2f(-b0), en1 = __builtin_amdgcn_exp2f(-b1);
            const float k0 = bf_lo(kv[i]), k1 = bf_hi(kv[i]);
            *(LAS unsigned*)(imgL + off_b(t, d0 >> 3) + (d0 & 7u) * 2u) = cvtpk(k0 * (en0 * gl0), k1 * (en1 * gl1));
            if (PASS) {
                const float eb0 = __builtin_amdgcn_exp2f(b0), eb1 = __builtin_amdgcn_exp2f(b1);
                const float q0 = bf_lo(qv[i]) * 0.08838834764831845f, q1 = bf_hi(qv[i]) * 0.08838834764831845f;
                *(LAS unsigned*)(imgK + off_b(t, pq >> 3) + (pq & 7u) * 2u) = cvtpk(k0 * en0, k1 * en1);
                *(LAS unsigned*)(imgQ + off_b(t, pq >> 3) + (pq & 7u) * 2u) = cvtpk(q0 * eb0, q1 * eb1);
            }
        }
        asm volatile("s_waitcnt vmcnt(0)" ::: "memory"); GLA_BAR();
        { int l2 = lane_o; asm volatile("" : "+v"(l2)); lane_s = l2; }
        const int hh = lane >> 5, r32 = lane & 31;
        if (c4 < 3) GLA_LOAD_QK(m0 + 64);
        LAS const unsigned char* myV = imgV + (wave >> 2) * 16384;
        bf16x8 Vf[4];
#pragma unroll
        for (int ks = 0; ks < 4; ++ks) Vf[ks] = tr_frag(myV, lane, wave & 3, ks);
        if (PASS) {
            bf16x8 SP[4][2];
#pragma unroll
            for (int db = 0; db < 4; ++db) { SP[db][0] = pack8(St[db], 0); SP[db][1] = pack8(St[db], 1); }
#pragma unroll
            for (int tb = 0; tb < 2; ++tb) {
                bf16x8 Qf[8];
#pragma unroll
                for (int s = 0; s < 8; ++s) Qf[s] = row_frag(imgQ, 32 * tb + r32, s, hh);
                f32x16 o;
#pragma unroll
                for (int i = 0; i < 16; ++i) o[i] = 0.f;
#pragma unroll
                for (int db = 0; db < 4; ++db) { o = GLA_MFMA(Qf[2 * db], SP[db][0], o); o = GLA_MFMA(Qf[2 * db + 1], SP[db][1], o); }
#pragma unroll
                for (int tb2 = 0; tb2 <= tb; ++tb2) {
                    f32x16 pt;
#pragma unroll
                    for (int i = 0; i < 16; ++i) pt[i] = 0.f;
#pragma unroll
                    for (int s = 0; s < 8; ++s) pt = GLA_MFMA(row_frag(imgK, 32 * tb2 + r32, s, hh), Qf[s], pt);
                    if (tb2 == tb) {
#pragma unroll
                        for (int i = 0; i < 16; ++i) pt[i] = (crow(i, hh) <= r32) ? pt[i] : 0.f;
                    }
                    o = GLA_MFMA(pack8(pt, 0), Vf[2 * tb2], o); o = GLA_MFMA(pack8(pt, 1), Vf[2 * tb2 + 1], o);
                }
#pragma unroll
                for (int i = 0; i < 16; ++i) Ot[(32 * tb + crow(i, hh)) * 256 + 32 * wave + r32] = o[i];
            }
        }
#pragma unroll
        for (int db = 0; db < 4; ++db) {
#pragma unroll
            for (int g4 = 0; g4 < 4; ++g4) { const f32x4 gv = *(const LAS f32x4*)(gc + 32 * db + 8 * g4 + 4 * hh);
                St[db][4 * g4 + 0] *= gv.x; St[db][4 * g4 + 1] *= gv.y; St[db][4 * g4 + 2] *= gv.z; St[db][4 * g4 + 3] *= gv.w; }
#pragma unroll
            for (int ks = 0; ks < 4; ++ks) St[db] = GLA_MFMA(tr_frag(imgL, lane, db, ks), Vf[ks], St[db]);
        }
        GLA_BAR();
        { int l3 = lane_o; asm volatile("" : "+v"(l3)); lane_s = l3; }
        if (PASS) {
#pragma unroll
            for (int rr = 0; rr < 8; ++rr) gpre[rr] = *(const GAS unsigned long long*)(U + (m0 + 8 * wave + rr) * LDU + UG + h * 256 + 4 * lane);
        }
        if (c4 < 3) { GLA_LOAD_V(m0 + 64); if (PASS) GLA_LOAD_B(m0 + 64); }
        if (PASS) {
            const f32x4 gh = *(const GAS f32x4*)(g_head + 4 * lane);
#pragma unroll
            for (int rr = 0; rr < 8; ++rr) { const int t = 8 * wave + rr;
                const f32x4 ov = *(const LAS f32x4*)(Ot + t * 256 + 4 * lane);
                float ss = (ov.x * ov.x + ov.y * ov.y) + (ov.z * ov.z + ov.w * ov.w);
                ss = wave_sum(ss); const float rn = 1.0f / sqrtf(ss * (1.0f / 256.0f) + EPS);
                const unsigned long long gw = gpre[rr];
                const float ga = bf_lo((unsigned)gw), gb = bf_hi((unsigned)gw), gcc = bf_lo((unsigned)(gw >> 32)), gd = bf_hi((unsigned)(gw >> 32));
                const float v0 = ov.x * rn * gh.x * (ga / (1.0f + __expf(-ga))), v1 = ov.y * rn * gh.y * (gb / (1.0f + __expf(-gb)));
                const float v2 = ov.z * rn * gh.z * (gcc / (1.0f + __expf(-gcc))), v3 = ov.w * rn * gh.w * (gd / (1.0f + __expf(-gd)));
                *(GAS unsigned long long*)(MIXIN + (m0 + t) * DM + h * 256 + 4 * lane) = (unsigned long long)cvtpk(v0, v1) | ((unsigned long long)cvtpk(v2, v3) << 32);
                if (rr & 1) asm volatile("" ::: "memory"); }
        }
    }
#undef lane
#undef tid
#undef GLA_LOAD_QK
#undef GLA_LOAD_V
#undef GLA_LOAD_B
    if (!PASS) {
#pragma unroll
        for (int db = 0; db < 4; ++db)
#pragma unroll
            for (int i = 0; i < 16; ++i) DS[(size_t)it * 32768 + (size_t)(32 * db + crow(i, hh0)) * 256 + 32 * wave + r320] = St[db][i];
        if (wave == 0) *(GAS f32x2_t*)(GS + (size_t)it * 128 + 2 * lane) = (f32x2_t){__builtin_amdgcn_exp2f(blsum[0]), __builtin_amdgcn_exp2f(blsum[1])};
    }
    __syncthreads();
}
__device__ __forceinline__ void scan(Frame& F, const Args& A) {
    PHASE_IDS();
    const int gtid = (int)blockIdx.x * (NWAVES * 64) + tid, nthreads = F.G * NWAVES * 64;
    const float* DS = (const float*)(A.ws + WS_DS); float* SIN = (float*)(A.ws + WS_SIN); const float* GS = (const float*)(A.ws + WS_GS);
    for (int idx = gtid; idx < 16 * 8192; idx += nthreads) {
        const int bh = idx >> 13, e4 = idx & 8191, d = e4 >> 6;
        f32x4 cur = (f32x4){0.f, 0.f, 0.f, 0.f};
#pragma unroll 4
        for (int s = 0; s < 16; ++s) { const size_t itx = (size_t)bh * 16 + s;
            *((GAS f32x4*)(SIN + itx * 32768) + e4) = cur;
            if (s < 15) { const float g = GS[itx * 128 + d]; const f32x4 dv = *((const GAS f32x4*)(DS + itx * 32768) + e4); cur = cur * g + dv; } }
    }
}
}
namespace sb {
using gla::f32x16; using gla::off_b; using gla::crow; using gla::tr_frag; using gla::row_frag; using gla::pack8; using gla::L2E;
constexpr float T2 = 30.0f * 1.4426950408889634f;
__device__ __forceinline__ void wave_item(Frame& F, const Args& A, int wi) {
    PHASE_IDS();
    const bf16* U = (const bf16*)(A.ws + WS_U); bf16* MIXIN = (bf16*)(A.ws + WS_MIXIN);
    const int hh0 = lane >> 5, r320 = lane & 31;
    const int kt0 = wi & 127, h = (wi >> 7) & 7, b = wi >> 10, t0 = 32 * kt0;
    LAS unsigned char* imgK = F.lds + wave * 16384; LAS unsigned char* imgV = imgK + 8192; LAS float* Of = (LAS float*)imgK;
    const size_t rowb = (size_t)b * SEQ;
    bf16x8 Qf[8];
#pragma unroll
    for (int s = 0; s < 8; ++s) Qf[s] = *(const GAS bf16x8*)(U + (rowb + t0 + r320) * LDU + USQ + h * 128 + 16 * s + 8 * hh0);
    f32x16 o[4];
#pragma unroll
    for (int c = 0; c < 4; ++c)
#pragma unroll
        for (int i = 0; i < 16; ++i) o[c][i] = 0.f;
    float R = 0.f;
    const float C = 0.08838834764831845f * L2E;
    v4u kx[8], vx[8];
#define SB_LOADK(KT) do { const int j0_ = 32 * (KT); _Pragma("unroll") for (int i = 0; i < 8; ++i) { const int n = lane + 64 * i, row = n >> 4, ch = n & 15; \
        kx[i] = *(const GAS v4u*)(U + (rowb + j0_ + row) * LDU + USK + h * 128 + 8 * ch); } } while (0)
#define SB_LOADV(KT) do { const int j0_ = 32 * (KT); _Pragma("unroll") for (int i = 0; i < 8; ++i) { const int n = lane + 64 * i, row = n >> 4, ch = n & 15; \
        vx[i] = *(const GAS v4u*)(U + (rowb + j0_ + row) * LDU + USV + h * 128 + 8 * ch); } } while (0)
    SB_LOADK(kt0);
    int lane_t = lane;
    for (int kt = kt0; kt >= 0; --kt) {
        { int lt = lane_o; asm volatile("" : "+v"(lt)); lane_t = lt; }
#define lane lane_t
        const int hh = lane >> 5, r32 = lane & 31;
#pragma unroll
        for (int i = 0; i < 8; ++i) { const int n = lane + 64 * i, row = n >> 4, ch = n & 15; *(LAS v4u*)(imgK + off_b(row, ch)) = kx[i]; }
        SB_LOADV(kt);
        f32x16 sacc;
#pragma unroll
        for (int i = 0; i < 16; ++i) sacc[i] = 0.f;
#pragma unroll
        for (int s = 0; s < 8; ++s) sacc = GLA_MFMA(row_frag(imgK, r32, s, hh), Qf[s], sacc);
        const bool diag = (kt == kt0);
        float lk[16], G[4], Gp[4];
#pragma unroll
        for (int i = 0; i < 16; ++i) { const float z2 = sacc[i] * C; const bool act = !diag || (crow(i, hh) < r32);
            const float sp = fmaxf(z2, 0.f) + __builtin_amdgcn_logf(1.0f + __builtin_amdgcn_exp2f(-fabsf(z2)));
            lk[i] = act ? -sp : 0.f; sacc[i] = act ? z2 : -3.0e38f; }
#pragma unroll
        for (int g = 0; g < 4; ++g) { G[g] = (lk[4 * g] + lk[4 * g + 1]) + (lk[4 * g + 2] + lk[4 * g + 3]); Gp[g] = __shfl_xor(G[g], 32); }
        float acc = R;
#pragma unroll
        for (int g = 3; g >= 0; --g) {
            const float offg = acc + (hh == 0 ? Gp[g] : 0.f);
            const float r3 = offg + lk[4 * g + 3], r2 = r3 + lk[4 * g + 2], r1 = r2 + lk[4 * g + 1], r0 = r1 + lk[4 * g];
            sacc[4 * g + 3] = __builtin_amdgcn_exp2f(sacc[4 * g + 3] + r3); sacc[4 * g + 2] = __builtin_amdgcn_exp2f(sacc[4 * g + 2] + r2);
            sacc[4 * g + 1] = __builtin_amdgcn_exp2f(sacc[4 * g + 1] + r1); sacc[4 * g] = __builtin_amdgcn_exp2f(sacc[4 * g] + r0);
            acc += G[g] + Gp[g];
        }
        R = acc;
#pragma unroll
        for (int i = 0; i < 8; ++i) { const int n = lane + 64 * i, row = n >> 4, ch = n & 15; *(LAS v4u*)(imgV + off_b(row, ch)) = vx[i]; }
        if (kt > 0) SB_LOADK(kt - 1);
        const bf16x8 w0 = pack8(sacc, 0), w1 = pack8(sacc, 1);
#pragma unroll
        for (int c = 0; c < 4; ++c) { o[c] = GLA_MFMA(w0, tr_frag(imgV, lane, c, 0), o[c]); o[c] = GLA_MFMA(w1, tr_frag(imgV, lane, c, 1), o[c]); }
        if (__ballot(R > -T2) == 0ull) break;
    }
#undef lane
#undef SB_LOADK
#undef SB_LOADV
#pragma unroll
    for (int c = 0; c < 4; ++c)
#pragma unroll
        for (int i = 0; i < 16; ++i) Of[crow(i, hh0) * 128 + 32 * c + r320] = o[c][i];
#pragma unroll
    for (int pz = 0; pz < 8; ++pz) { const int row = 4 * pz + (lane >> 4), c8 = 8 * (lane & 15);
        const f32x4 a = *(const LAS f32x4*)(Of + row * 128 + c8), bq = *(const LAS f32x4*)(Of + row * 128 + c8 + 4);
        const v4u gw = *(const GAS v4u*)(U + (rowb + t0 + row) * LDU + USG + h * 128 + c8);
        const float ov[8] = {a.x, a.y, a.z, a.w, bq.x, bq.y, bq.z, bq.w}; const unsigned gws[4] = {gw.x, gw.y, gw.z, gw.w}; unsigned ow[4];
#pragma unroll
        for (int q = 0; q < 4; ++q) { const float g0 = bf_lo(gws[q]), g1 = bf_hi(gws[q]);
            ow[q] = gla::cvtpk(ov[2 * q] * (g0 / (1.0f + __expf(-g0))), ov[2 * q + 1] * (g1 / (1.0f + __expf(-g1)))); }
        v4u w; w.x = ow[0]; w.y = ow[1]; w.z = ow[2]; w.w = ow[3];
        *(GAS v4u*)(MIXIN + (rowb + t0 + row) * DM + 1024 + h * 128 + c8) = w; }
}
}

__device__ __forceinline__ void p0_prologue(Frame& F, const Args& A) {
    PHASE_IDS();
    const float* x = A.in[0]; const float* p = A.in[1]; const float* g_pre = A.in[2]; const float* w_in = A.in[3];
    const float* w_out = A.in[7]; const float* w_g = A.in[9]; const float* w_p = A.in[11];
    unsigned char* ws = A.ws;
    bf16* WinT = (bf16*)(ws + WS_WIN); bf16* WoutT = (bf16*)(ws + WS_WOUT); bf16* WgT = (bf16*)(ws + WS_WG); bf16* WpT = (bf16*)(ws + WS_WP);
    bf16* XB = (bf16*)(ws + WS_XB); bf16* PIN = (bf16*)(ws + WS_PIN); float* RS = (float*)(ws + WS_RS); float* GLR = (float*)(ws + WS_GLR);
    LAS float* scr = (LAS float*)(F.lds + RING_OFF + wave * 16640);
    const int gw = F.vcu * NWAVES + wave, NGW = F.G * NWAVES;
    for (int repa = 0; repa < REP0A; ++repa) {
    constexpr int I_IN = (DM / 64) * (LDU / 64), I_SQ = (DM / 64) * (DM / 64), I_P = (PLE / 64) * (DM / 64);
    constexpr int NITEMS = I_IN + 2 * I_SQ + I_P;
    for (int it = gw; it < NITEMS; it += NGW) {
        int r = it;
        if (r < I_IN) { const int ng = LDU / 64, kb = r / ng, g = r % ng, nd = 64 * g; p0_item64(w_in, DIN_SRC, DM, WinT, nd + (nd >= 3072 ? 16 : 0), nd, 64 * kb, g_pre, scr, lane); continue; }
        r -= I_IN;
        if (r < I_SQ) { const int ng = DM / 64, kb = r / ng, g = r % ng; p0_item64(w_out, DM, DM, WoutT, 64 * g, 64 * g, 64 * kb, nullptr, scr, lane); continue; }
        r -= I_SQ;
        if (r < I_SQ) { const int ng = DM / 64, kb = r / ng, g = r % ng; p0_item64(w_g, DM, DM, WgT, 64 * g, 64 * g, 64 * kb, nullptr, scr, lane); continue; }
        r -= I_SQ;
        { const int ng = DM / 64, kb = r / ng, g = r % ng; p0_item64(w_p, DM, PLE, WpT, 64 * g, 64 * g, 64 * kb, nullptr, scr, lane); }
    }
    for (int m = gw; m < M; m += NGW) {
        const f32x4 v = *((const GAS f32x4*)(p + (size_t)m * PLE) + lane);
        *((GAS unsigned long long*)(PIN + (size_t)m * PLE) + lane) = (unsigned long long)pk2(v.x, v.y) | ((unsigned long long)pk2(v.z, v.w) << 32);
    }
    }
    for (int repb = 0; repb < REP0B; ++repb)
    {
        LAS v4u* tab = (LAS v4u*)(F.lds + P0_TAB_OFF); LAS float* part = (LAS float*)(F.lds + P0_PART_OFF);
        __syncthreads();
        for (int e = tid; e < 64 * 64; e += NWAVES * 64) { const int kb = e >> 6, ln = e & 63, k0 = 32 * kb + 8 * (ln >> 4), n = ln & 15; float wv[8];
#pragma unroll
            for (int jj = 0; jj < 8; ++jj) wv[jj] = w_in[(size_t)(k0 + jj) * DIN_SRC + 3072 + n] * g_pre[k0 + jj];
            v4u o; o.x = pk2(wv[0], wv[1]); o.y = pk2(wv[2], wv[3]); o.z = pk2(wv[4], wv[5]); o.w = pk2(wv[6], wv[7]); tab[e] = o; }
        __syncthreads();
        for (int rb = F.vcu; rb < M / 64; rb += F.G) {
            const int rg = wave & 3, kh = wave >> 2, row = 64 * rb + 16 * rg + (lane & 15), kq = lane >> 4;
            const GAS f32x4* xr = (const GAS f32x4*)(x + (size_t)row * DM + 1024 * kh + 8 * kq);
            GAS v4u* xo = (GAS v4u*)(XB + (size_t)row * DM + 1024 * kh + 8 * kq);
            f32x4 acc = (f32x4){0.f, 0.f, 0.f, 0.f}; float ss = 0.f;
#pragma unroll 8
            for (int kb = 0; kb < 32; ++kb) {
                const f32x4 a = xr[8 * kb], c = xr[8 * kb + 1];
                ss += (a.x * a.x + a.y * a.y) + (a.z * a.z + a.w * a.w) + (c.x * c.x + c.y * c.y) + (c.z * c.z + c.w * c.w);
                v4u pa; pa.x = gla::cvtpk(a.x, a.y); pa.y = gla::cvtpk(a.z, a.w); pa.z = gla::cvtpk(c.x, c.y); pa.w = gla::cvtpk(c.z, c.w);
                xo[4 * kb] = pa;
                const v4u pb = tab[(32 * kh + kb) * 64 + lane];
                acc = __builtin_amdgcn_mfma_f32_16x16x32_bf16(__builtin_bit_cast(bf16x8, pa), __builtin_bit_cast(bf16x8, pb), acc, 0, 0, 0);
            }
            ss += __shfl_xor(ss, 16); ss += __shfl_xor(ss, 32);
            if (kh == 1) { LAS float* pp = part + (rg * 64 + lane) * 5; pp[0] = acc[0]; pp[1] = acc[1]; pp[2] = acc[2]; pp[3] = acc[3]; pp[4] = ss; }
            __syncthreads();
            if (kh == 0) { const LAS float* pp = part + (rg * 64 + lane) * 5; acc[0] += pp[0]; acc[1] += pp[1]; acc[2] += pp[2]; acc[3] += pp[3]; ss += pp[4];
                const float r = 1.0f / sqrtf(ss * (1.0f / DM) + EPS);
#pragma unroll
                for (int q = 0; q < 4; ++q) { const float rq = __shfl(r, 4 * kq + q); GLR[(size_t)(64 * rb + 16 * rg + 4 * kq + q) * 16 + (lane & 15)] = acc[q] * rq; }
                if (lane < 16) RS[64 * rb + 16 * rg + lane] = r; }
            __syncthreads();
        }
    }
}

__device__ __forceinline__ void p5_postnorm(Frame& F, const Args& A) {
    PHASE_IDS();
    const float* x = A.in[0]; const float* g_post = A.in[8]; const bf16* mixb = (const bf16*)(A.ws + WS_MIX); bf16* HB = (bf16*)(A.ws + WS_XB);
    const int gw = F.vcu * NWAVES + wave, NGW = F.G * NWAVES;
    for (int m = gw; m < M; m += NGW) {
        const GAS v4u* mr = (const GAS v4u*)(mixb + (size_t)m * DM) + lane;
        const GAS f32x4* xr = (const GAS f32x4*)(x + (size_t)m * DM) + 2 * lane;
        v4u mv[4]; f32x4 xa[4], xb[4]; float ss = 0.f;
#pragma unroll
        for (int j = 0; j < 4; ++j) { mv[j] = mr[64 * j]; xa[j] = xr[128 * j]; xb[j] = xr[128 * j + 1]; }
        float mf[4][8];
#pragma unroll
        for (int j = 0; j < 4; ++j) { const unsigned w4[4] = {mv[j].x, mv[j].y, mv[j].z, mv[j].w};
#pragma unroll
            for (int q = 0; q < 4; ++q) { mf[j][2 * q] = bf_lo(w4[q]); mf[j][2 * q + 1] = bf_hi(w4[q]); ss += mf[j][2 * q] * mf[j][2 * q] + mf[j][2 * q + 1] * mf[j][2 * q + 1]; } }
        ss = wave_sum(ss); const float r = 1.0f / sqrtf(ss * (1.0f / DM) + EPS);
        GAS v4u* ho = (GAS v4u*)(HB + (size_t)m * DM) + lane;
#pragma unroll
        for (int j = 0; j < 4; ++j) { const f32x4 ga = *((const GAS f32x4*)g_post + 2 * lane + 128 * j), gb = *((const GAS f32x4*)g_post + 2 * lane + 128 * j + 1);
            v4u o; o.x = gla::cvtpk(xa[j].x + mf[j][0] * r * ga.x, xa[j].y + mf[j][1] * r * ga.y); o.y = gla::cvtpk(xa[j].z + mf[j][2] * r * ga.z, xa[j].w + mf[j][3] * r * ga.w);
            o.z = gla::cvtpk(xb[j].x + mf[j][4] * r * gb.x, xb[j].y + mf[j][5] * r * gb.y); o.w = gla::cvtpk(xb[j].z + mf[j][6] * r * gb.z, xb[j].w + mf[j][7] * r * gb.w);
            ho[64 * j] = o; }
    }
}

__global__ void __launch_bounds__(NWAVES * 64, 2) fwd_megakernel(Args args) {
    extern __shared__ __attribute__((aligned(16))) unsigned char lds[];
    Frame F;
    F.lds = (LAS unsigned char*)lds;
    F.MISC = (volatile LAS unsigned*)(F.lds + MISC_OFF);
    F.wave = __builtin_amdgcn_readfirstlane(threadIdx.x >> 6);
    F.G = gridDim.x; { const int bx = blockIdx.x; F.vcu = (F.G % 8 == 0) ? (bx % 8) * (F.G / 8) + bx / 8 : bx; }
    unsigned char* ws = args.ws;
    F.ctl = (gu32*)(ws + WS_CTL);
    for (int u = threadIdx.x; u < (LDS_BYTES - LDSCTL_OFF) / 4; u += NWAVES * 64) ((LAS unsigned*)(F.lds + LDSCTL_OFF))[u] = 0u;
    __syncthreads();
    XcdBarrier bar = xcd_barrier_post((unsigned*)(F.ctl + CW_BAR), F.MISC + 8);

    bf16* WinT = (bf16*)(ws + WS_WIN); bf16* WoutT = (bf16*)(ws + WS_WOUT); bf16* WgT = (bf16*)(ws + WS_WG); bf16* WpT = (bf16*)(ws + WS_WP);
    bf16* XB = (bf16*)(ws + WS_XB); bf16* PIN = (bf16*)(ws + WS_PIN); float* RS = (float*)(ws + WS_RS);
    bf16* U = (bf16*)(ws + WS_U); bf16* PB = (bf16*)(ws + WS_PB); bf16* MIXIN = (bf16*)(ws + WS_MIXIN);

    for (int rep = 0; rep < REP0; ++rep) {
    p0_prologue(F, args);
    xcd_barrier(bar); }
    for (int rep = 0; rep < REP1; ++rep) {
    { pg8::Gemm g{XB, WinT, M, LDU, DM}; pg8::StaticOrder S; S.init(M, LDU, F.G, (int)blockIdx.x);
      pg8::EpiB16 E{U, LDU, RS};
      pg8::gemm_phase<pg8::EpiB16, pg8::StaticOrder, true, true>(F.lds + RING_OFF, g, S, E, F.wave); }
    xcd_barrier(bar); }
    for (int rep = 0; rep < REP2; ++rep) {
    for (int r2 = 0; r2 < REP2A; ++r2)
    for (int it = (int)blockIdx.x; it < BATCH * GH * 16; it += F.G) gla::item<0>(F, args, it);
    { const int gw = (int)blockIdx.x * NWAVES + F.wave, NGW = F.G * NWAVES;
      for (int r2 = 0; r2 < REP2B; ++r2)
      for (int wi = gw; wi < BATCH * SH * (SEQ / 32); wi += NGW) sb::wave_item(F, args, wi); }
    xcd_barrier(bar); }
    for (int rep = 0; rep < REP3; ++rep) {
    for (int r3 = 0; r3 < REP3A; ++r3) {
    gla::scan(F, args);
    xcd_barrier(bar); }
    for (int it = (int)blockIdx.x; it < BATCH * GH * 16; it += F.G) gla::item<1>(F, args, it);
    xcd_barrier(bar); }
    for (int rep = 0; rep < REP4; ++rep) {
    { pg8::Gemm g{MIXIN, WoutT, M, DM, DM}; pg8::StaticOrder S; S.init(M, DM, F.G, (int)blockIdx.x);
      pg8::EpiB16 E{(bf16*)(ws + WS_MIX), DM, nullptr};
      pg8::gemm_phase<pg8::EpiB16, pg8::StaticOrder, true, true>(F.lds + RING_OFF, g, S, E, F.wave); }
    { pg8::Gemm g{PIN, WpT, M, DM, PLE}; pg8::StaticOrder S; S.init(M, DM, F.G, (int)blockIdx.x);
      pg8::EpiB16 E{PB, DM, nullptr};
      pg8::gemm_phase<pg8::EpiB16, pg8::StaticOrder, true, true>(F.lds + RING_OFF, g, S, E, F.wave); }
    xcd_barrier(bar); }
    for (int rep = 0; rep < REP5; ++rep) {
    p5_postnorm(F, args);
    xcd_barrier(bar); }
    for (int rep = 0; rep < REP6; ++rep)
    { pg8::Gemm g{XB, WgT, M, DM, DM}; pg8::StaticOrder S; S.init(M, DM, F.G, (int)blockIdx.x);
      pg8::EpiFinal E{XB, args.out, PB, args.in[10], DM};
      pg8::gemm_phase<pg8::EpiFinal, pg8::StaticOrder, true, true>(F.lds + RING_OFF, g, S, E, F.wave); }
}

extern "C" void kernel_launch(void* const* d_in, const int* in_sizes, int n_in, void* d_out, int out_size, void* d_ws, size_t ws_size, hipStream_t stream) {
    static int grid = 0;
    if (grid == 0) {
        if (n_in != 12 || in_sizes[0] != M * DM || out_size != M * DM || ws_size < WS_END) { fprintf(stderr, "kernel_launch: unexpected shapes: n_in %d in0 %d out %d ws %zu (need %zu)\n", n_in, n_in > 0 ? in_sizes[0] : -1, out_size, ws_size, (size_t)WS_END); grid = -1; return; }
        int dev = 0, cus = 0, per_cu = 0;
        if (hipGetDevice(&dev) != hipSuccess || hipDeviceGetAttribute(&cus, hipDeviceAttributeMultiprocessorCount, dev) != hipSuccess) { grid = -1; return; }
        if (hipFuncSetAttribute((const void*)fwd_megakernel, hipFuncAttributeMaxDynamicSharedMemorySize, LDS_BYTES) != hipSuccess) { fprintf(stderr, "kernel_launch: hipFuncSetAttribute failed\n"); grid = -1; return; }
        if (hipOccupancyMaxActiveBlocksPerMultiprocessor(&per_cu, (const void*)fwd_megakernel, NWAVES * 64, LDS_BYTES) != hipSuccess || per_cu < 1)
            fprintf(stderr, "kernel_launch: note: occupancy query reports %d workgroups per CU\n", per_cu);
        (void)hipGetLastError();
        grid = cus;
    }
    if (grid < 0) return;
    if (hipMemsetAsync((char*)d_ws + WS_CTL, 0, CTL_ZERO_BYTES, stream) != hipSuccess) { fprintf(stderr, "kernel_launch: hipMemsetAsync failed\n"); return; }
    Args a{};
    for (int i = 0; i < 12; ++i) a.in[i] = (const float*)d_in[i];
    a.out = (float*)d_out; a.ws = (unsigned char*)d_ws;
    hipLaunchKernelGGL(fwd_megakernel, dim3(grid), dim3(NWAVES * 64), LDS_BYTES, stream, a);
    const hipError_t le = hipPeekAtLastError();
    if (le != hipSuccess) fprintf(stderr, "kernel_launch: launch failed: %s\n", hipGetErrorName(le));
}
```

```cpp
#include <hip/hip_runtime.h>
#include <cstdio>
#include <cstdint>
namespace pg8 {
#define PG8_LAS __attribute__((address_space(3)))
typedef unsigned short bf16_t;
typedef short bf16x8 __attribute__((ext_vector_type(8)));
typedef float f32x4 __attribute__((ext_vector_type(4)));
typedef unsigned u32x4 __attribute__((ext_vector_type(4)));
constexpr int BM = 256, BK = 64, HALF = 128, HTB = HALF * BK * 2  , STAGE_BYTES = 8 * HTB, NXCD = 8, WGM = 8;

__host__ __device__ __forceinline__ int lds_byte(int r, int c) { const int st = (r >> 4) * 2 + (c >> 5), rr = r & 15, cc = c & 31, ob = rr * 64 + cc * 2; return st * 1024 + (ob ^ (((ob >> 9) & 1) << 5)); }
__host__ __device__ __forceinline__ void stage_rc(int b, int& R, int& C) { const int st = b / 1024, sb = b % 1024, swz = sb ^ (((sb >> 9) & 1) << 5); R = (st >> 1) * 16 + swz / 64; C = (st & 1) * 32 + (swz % 64) / 2; }
__host__ __device__ __forceinline__ int perm32(int rho) { const int n = rho >> 4, i = rho & 15; return 8 * (i >> 2) + 4 * n + (i & 3); }

struct Unit { int pm, pn; };
struct Gemm { const bf16_t* A; const bf16_t* Bt; int M, N, K; };

struct StaticOrder {
    int nM, nN, nwg, G, c;
    __host__ __device__ void init(int M, int N, int G_, int c_) { nM = M / BM; nN = N / BM; nwg = nM * nN; G = G_; c = c_; }
    __host__ __device__ bool next(int i, Unit& u) const {
        const long L = (long)i * G + c; if (L >= nwg) return false;
        int wgid = (int)L; { const int q = nwg / NXCD, r = nwg % NXCD, xcd = wgid % NXCD, off = wgid / NXCD; wgid = (xcd < r ? xcd * (q + 1) : r * (q + 1) + (xcd - r) * q) + off; }
        const int nig = WGM * nN, gid = wgid / nig, fm = gid * WGM, gsz = (nM - fm) < WGM ? (nM - fm) : WGM;
        u.pm = fm + ((wgid % nig) % gsz); u.pn = (wgid % nig) / gsz; return true;
    }
    __device__ __forceinline__ void a_ready(const Unit&) const {}
    __device__ __forceinline__ void done(const Unit&) const {}
};

__device__ __forceinline__ unsigned cvt_pk_bf16(float lo, float hi) { unsigned r; asm volatile("v_cvt_pk_bf16_f32 %0, %1, %2" : "=v"(r) : "v"(lo), "v"(hi)); return r; }
typedef float f32x2 __attribute__((ext_vector_type(2)));
__device__ __forceinline__ f32x2 gelu_pk(f32x2 v) {
    const f32x2 av = __builtin_elementwise_abs(v), d = av * 0.2316418882f + 1.0f;
    f32x2 t; t.x = __builtin_amdgcn_rcpf(d.x); t.y = __builtin_amdgcn_rcpf(d.y);
    f32x2 q = t * 0.5307027145f + (-0.7265760135f); q = q * t + 0.7107068705f; q = q * t + (-0.142248368f); q = q * t + 0.127414796f; q = q * t;
    const f32x2 s = (v * v) * (-0.72134752044f);
    f32x2 e; e.x = __builtin_amdgcn_exp2f(s.x); e.y = __builtin_amdgcn_exp2f(s.y);
    const f32x2 m = v * (q * e), r = v - m;
    f32x2 o; o.x = v.x < 0.f ? m.x : r.x; o.y = v.y < 0.f ? m.y : r.y; return o;
}

template <int ACT  > struct EpiBf16 {
    static constexpr bool PERM = true, AFTER_DRAIN = false; static_assert(ACT == 0 || ACT == 1, "EpiBf16: ACT is 0 (none) or 1 (gelu_pk)");
    bf16_t* O; int ldc; const float* bias; int split_cols; size_t split_stride; float scale0;
    __device__ __forceinline__ void operator()(const f32x4 (&acc)[2][2][4][2], const Unit& u, int wr, int wc, int fr, int fq) const {
        const int row0 = u.pm * BM + wr * 64 + fr; int colt = u.pn * BM; bf16_t* base = O;
        float sc = 1.f; if (split_cols) { const int t = colt / split_cols; base += (size_t)t * split_stride; colt -= t * split_cols; if (t == 0) sc = scale0; }
        const int col0 = colt + wc * 32 + 8 * fq, bcol0 = u.pn * BM + wc * 32 + 8 * fq;
        f32x4 bv[2][2];
#pragma unroll
        for (int bj = 0; bj < 2; ++bj)
#pragma unroll
            for (int n = 0; n < 2; ++n) bv[bj][n] = bias ? *(const f32x4*)(bias + bcol0 + bj * HALF + 4 * n) : (f32x4){0.f, 0.f, 0.f, 0.f};
#pragma unroll
        for (int ai = 0; ai < 2; ++ai)
#pragma unroll
            for (int m = 0; m < 4; ++m) { bf16_t* rowp = base + (size_t)(row0 + ai * HALF + m * 16) * ldc + col0;
#pragma unroll
                for (int bj = 0; bj < 2; ++bj) { f32x4 v0 = acc[ai][bj][m][0] + bv[bj][0], v1 = acc[ai][bj][m][1] + bv[bj][1];
                    if (ACT == 1) { f32x2 a = gelu_pk((f32x2){v0[0], v0[1]}), b = gelu_pk((f32x2){v0[2], v0[3]}), c = gelu_pk((f32x2){v1[0], v1[1]}), d = gelu_pk((f32x2){v1[2], v1[3]});
                        v0 = (f32x4){a.x, a.y, b.x, b.y}; v1 = (f32x4){c.x, c.y, d.x, d.y}; }
                    v0 = v0 * sc; v1 = v1 * sc; u32x4 w; w.x = cvt_pk_bf16(v0[0], v0[1]); w.y = cvt_pk_bf16(v0[2], v0[3]); w.z = cvt_pk_bf16(v1[0], v1[1]); w.w = cvt_pk_bf16(v1[2], v1[3]);
                    *(u32x4*)(rowp + bj * HALF) = w; } }
    }
};
__device__ __forceinline__ int epi_col0(const Unit& u, int wc, int fq) { return u.pn * BM + 64 * wc + 8 * fq; }
struct EpiB16 {
    static constexpr bool PERM = true, AFTER_DRAIN = false;
    bf16_t* O; int ldc; const float* rs;
    __device__ __forceinline__ void operator()(const f32x4 (&acc)[2][2][4][2], const Unit& u, int wr, int wc, int fr, int fq) const {
        const int row0 = u.pm * BM + wr * 64 + fr; const int col0 = epi_col0(u, wc, fq);
#pragma unroll
        for (int ai = 0; ai < 2; ++ai)
#pragma unroll
            for (int m = 0; m < 4; ++m) { const int row = row0 + ai * HALF + m * 16; const float sc = rs ? rs[row] : 1.0f; bf16_t* rowp = O + (size_t)row * ldc + col0;
#pragma unroll
                for (int bj = 0; bj < 2; ++bj) { const f32x4 v0 = acc[ai][bj][m][0] * sc, v1 = acc[ai][bj][m][1] * sc;
                    u32x4 w; w.x = cvt_pk_bf16(v0[0], v0[1]); w.y = cvt_pk_bf16(v0[2], v0[3]); w.z = cvt_pk_bf16(v1[0], v1[1]); w.w = cvt_pk_bf16(v1[2], v1[3]);
                    *(u32x4*)(rowp + 32 * bj) = w; } }
    }
};
struct EpiFinal {
    static constexpr bool PERM = true, AFTER_DRAIN = false;
    const bf16_t* H; float* O; const bf16_t* P; const float* bg; int ldc;
    __device__ __forceinline__ void operator()(const f32x4 (&acc)[2][2][4][2], const Unit& u, int wr, int wc, int fr, int fq) const {
        const int row0 = u.pm * BM + wr * 64 + fr, col0 = epi_col0(u, wc, fq);
        f32x4 bv[2][2];
#pragma unroll
        for (int bj = 0; bj < 2; ++bj)
#pragma unroll
            for (int n = 0; n < 2; ++n) bv[bj][n] = *(const f32x4*)(bg + col0 + 32 * bj + 4 * n);
#pragma unroll
        for (int ai = 0; ai < 2; ++ai)
#pragma unroll
            for (int m = 0; m < 4; ++m) { const size_t off = (size_t)(row0 + ai * HALF + m * 16) * ldc + col0;
#pragma unroll
                for (int bj = 0; bj < 2; ++bj) { const size_t o2 = off + 32 * bj;
                    const u32x4 hw = *(const u32x4*)(H + o2), pw = *(const u32x4*)(P + o2);
                    const unsigned hws[4] = {hw.x, hw.y, hw.z, hw.w}, pws[4] = {pw.x, pw.y, pw.z, pw.w};
#pragma unroll
                    for (int n = 0; n < 2; ++n) { const f32x4 a = acc[ai][bj][m][n] + bv[bj][n]; f32x4 o;
                        o[0] = __uint_as_float(hws[2 * n] << 16) + __uint_as_float(pws[2 * n] << 16) / (1.0f + __expf(-a[0]));
                        o[1] = __uint_as_float(hws[2 * n] & 0xffff0000u) + __uint_as_float(pws[2 * n] & 0xffff0000u) / (1.0f + __expf(-a[1]));
                        o[2] = __uint_as_float(hws[2 * n + 1] << 16) + __uint_as_float(pws[2 * n + 1] << 16) / (1.0f + __expf(-a[2]));
                        o[3] = __uint_as_float(hws[2 * n + 1] & 0xffff0000u) + __uint_as_float(pws[2 * n + 1] & 0xffff0000u) / (1.0f + __expf(-a[3]));
                        *(f32x4*)(O + o2 + 4 * n) = o; } }
                if (m & 1) asm volatile("" ::: "memory"); }
    }
};
template <class Epi, class Sched, bool ALIGN_EPI = false, bool SP2 = false>
__device__ __forceinline__ void gemm_phase(PG8_LAS unsigned char* lds, const Gemm g, const Sched& S, const Epi& E, const int wave_in  ) {
    int lane_; asm volatile("v_mbcnt_lo_u32_b32 %0, -1, 0\n\tv_mbcnt_hi_u32_b32 %0, -1, %0" : "=v"(lane_));
    const int wid = wave_in, lane = lane_, tid = wid * 64 + lane, wr = wid >> 2, wc = wid & 3, fr = lane & 15, fq = lane >> 4;
    const int K = g.K, nt = K / BK;
    unsigned voffA[2], voffB[2];
#pragma unroll
    for (int i = 0; i < 2; ++i) { int R, C; stage_rc(tid * 16 + i * 8192, R, C); const int Rb = Epi::PERM ? ((R & ~31) + perm32(R & 31)) : R;
        voffA[i] = (unsigned)(R * K + C) * 2u; voffB[i] = (unsigned)(Rb * K + C) * 2u; }
    const size_t kstep = (size_t)(BK * 2);
    const size_t hstep = (size_t)HALF * K * 2;
    const size_t tstep = 2 * hstep;
    const unsigned ldsw = (unsigned)wid * 1024u;
    const int aoff = lds_byte(wr * 64 + fr, fq * 8), boff = lds_byte(wc * 32 + fr, fq * 8);
#define PG8_SA(b, h) (((b) * 2 + (h)) * HTB)
#define PG8_SB(b, h) ((4 + (b) * 2 + (h)) * HTB)
#define PG8_STAGE(bufoff, gbase, voff) do { _Pragma("unroll") for (int _i = 0; _i < 2; ++_i) \
        __builtin_amdgcn_global_load_lds((const unsigned*)((const char*)(gbase) + (voff)[_i]), (PG8_LAS unsigned*)(lds + (bufoff) + ldsw + _i * 8192), 16, 0, 0); } while (0)
#define PG8_LDA(dst, b, h) do { _Pragma("unroll") for (int m = 0; m < 4; ++m) _Pragma("unroll") for (int k = 0; k < 2; ++k) dst[m][k] = *(const PG8_LAS bf16x8*)(lds + PG8_SA(b, h) + aoff + m * 2048 + k * 1024); } while (0)
#define PG8_LDB(dst, b, h) do { _Pragma("unroll") for (int n = 0; n < 2; ++n) _Pragma("unroll") for (int k = 0; k < 2; ++k) dst[n][k] = *(const PG8_LAS bf16x8*)(lds + PG8_SB(b, h) + boff + n * 2048 + k * 1024); } while (0)
#define PG8_MMA(ai, bj, At, Bt) do { __builtin_amdgcn_s_setprio(1); _Pragma("unroll") for (int m = 0; m < 4; ++m) _Pragma("unroll") for (int n = 0; n < 2; ++n) _Pragma("unroll") for (int k = 0; k < 2; ++k) \
        acc[ai][bj][m][n] = __builtin_amdgcn_mfma_f32_16x16x32_bf16(Bt[n][k], At[m][k], acc[ai][bj][m][n], 0, 0, 0); __builtin_amdgcn_s_setprio(0); } while (0)
#define PG8_WAIT_V(n) asm volatile("s_waitcnt vmcnt(" #n ")" ::: "memory")
#define PG8_WAIT_L(n) asm volatile("s_waitcnt lgkmcnt(" #n ")" ::: "memory")
#define PG8_BAR __builtin_amdgcn_s_barrier()
#define PG8_SCHED __builtin_amdgcn_sched_barrier(0)
    Unit cur, nxt; int ui = 0;
    if (!S.next(0, cur)) return;
    f32x4 acc[2][2][4][2];
#pragma unroll
    for (int a = 0; a < 2; ++a)
#pragma unroll
        for (int b = 0; b < 2; ++b)
#pragma unroll
            for (int m = 0; m < 4; ++m)
#pragma unroll
                for (int n = 0; n < 2; ++n) acc[a][b][m][n] = (f32x4){0.f, 0.f, 0.f, 0.f};
    bf16x8 At[4][2], B0[2][2], B1[2][2];
    const char* cA = (const char*)g.A + (size_t)cur.pm * tstep; const char* cB = (const char*)g.Bt + (size_t)cur.pn * tstep;
    S.a_ready(cur);
    if constexpr (SP2) {
        PG8_STAGE(PG8_SB(0, 0), cB, voffB); PG8_STAGE(PG8_SB(0, 1), cB + hstep, voffB); PG8_STAGE(PG8_SA(0, 0), cA, voffA); PG8_STAGE(PG8_SA(0, 1), cA + hstep, voffA);
        if (wr == 1) PG8_BAR;
        PG8_WAIT_V(2); PG8_BAR;
        PG8_STAGE(PG8_SB(1, 0), cB + kstep, voffB); PG8_STAGE(PG8_SA(1, 0), cA + kstep, voffA); PG8_STAGE(PG8_SB(1, 1), cB + hstep + kstep, voffB);
        PG8_WAIT_V(6); PG8_BAR;
    } else {
        PG8_STAGE(PG8_SB(0, 0), cB, voffB); PG8_STAGE(PG8_SA(0, 0), cA, voffA); PG8_STAGE(PG8_SB(0, 1), cB + hstep, voffB); PG8_STAGE(PG8_SA(0, 1), cA + hstep, voffA);
        if (wr == 1) PG8_BAR;
        PG8_WAIT_V(4); PG8_BAR;
        PG8_STAGE(PG8_SB(1, 0), cB + kstep, voffB); PG8_STAGE(PG8_SA(1, 0), cA + kstep, voffA); PG8_STAGE(PG8_SB(1, 1), cB + hstep + kstep, voffB);
        PG8_WAIT_V(6); PG8_BAR;
    }
    for (;;) {
        const bool has_next = S.next(ui + 1, nxt);
        const char* nA = has_next ? (const char*)g.A + (size_t)nxt.pm * tstep : cA; const char* nB = has_next ? (const char*)g.Bt + (size_t)nxt.pn * tstep : cB;
        for (int t = 0; t < nt; t += 2) {
            const bool last = (t == nt - 2);
            const char* a1 = cA + (size_t)(t + 1) * kstep;
            const char* a2 = last ? nA : cA + (size_t)(t + 2) * kstep; const char* b2 = last ? nB : cB + (size_t)(t + 2) * kstep;
            const char* a3 = a2 + kstep; const char* b3 = b2 + kstep;
            if (last && has_next) S.a_ready(nxt);
            if constexpr (SP2) {
            PG8_LDB(B0, 0, 0); PG8_LDB(B1, 0, 1); PG8_SCHED; PG8_LDA(At, 0, 0); PG8_STAGE(PG8_SA(1, 1), a1 + hstep, voffA);
            PG8_WAIT_V(8); PG8_WAIT_L(0); PG8_BAR; PG8_MMA(0, 0, At, B0); PG8_MMA(0, 1, At, B1); PG8_BAR; PG8_SCHED;
            PG8_LDA(At, 0, 1); PG8_STAGE(PG8_SB(0, 0), b2, voffB); PG8_STAGE(PG8_SB(0, 1), b2 + hstep, voffB); PG8_STAGE(PG8_SA(0, 0), a2, voffA);
            PG8_WAIT_V(8); PG8_WAIT_L(0); PG8_BAR; PG8_MMA(1, 0, At, B0); PG8_MMA(1, 1, At, B1); PG8_BAR; PG8_SCHED;
            PG8_LDB(B0, 1, 0); PG8_LDB(B1, 1, 1); PG8_SCHED; PG8_LDA(At, 1, 0); PG8_STAGE(PG8_SA(0, 1), a2 + hstep, voffA);
            PG8_WAIT_V(8); PG8_WAIT_L(0); PG8_BAR; PG8_MMA(0, 0, At, B0); PG8_MMA(0, 1, At, B1); PG8_BAR; PG8_SCHED;
            PG8_LDA(At, 1, 1); PG8_STAGE(PG8_SB(1, 0), b3, voffB); PG8_STAGE(PG8_SB(1, 1), b3 + hstep, voffB); PG8_STAGE(PG8_SA(1, 0), a3, voffA);
            PG8_WAIT_V(8); PG8_WAIT_L(0); PG8_BAR; PG8_MMA(1, 0, At, B0); PG8_MMA(1, 1, At, B1); PG8_BAR; PG8_SCHED;
            } else {
            PG8_LDB(B0, 0, 0); PG8_SCHED; PG8_LDA(At, 0, 0); PG8_STAGE(PG8_SA(1, 1), a1 + hstep, voffA);
            PG8_WAIT_L(8); PG8_BAR; PG8_WAIT_L(0); PG8_MMA(0, 0, At, B0); PG8_BAR; PG8_SCHED;
            PG8_LDB(B1, 0, 1); PG8_STAGE(PG8_SB(0, 0), b2, voffB);
            PG8_BAR; PG8_WAIT_L(0); PG8_MMA(0, 1, At, B1); PG8_BAR;
            PG8_LDA(At, 0, 1); PG8_STAGE(PG8_SA(0, 0), a2, voffA);
            PG8_BAR; PG8_WAIT_L(0); PG8_MMA(1, 0, At, B0); PG8_BAR; PG8_SCHED;
            PG8_STAGE(PG8_SB(0, 1), b2 + hstep, voffB);
            PG8_WAIT_V(6); PG8_BAR; PG8_MMA(1, 1, At, B1); PG8_BAR;
            PG8_LDB(B0, 1, 0); PG8_SCHED; PG8_LDA(At, 1, 0); PG8_STAGE(PG8_SA(0, 1), a2 + hstep, voffA);
            PG8_WAIT_L(8); PG8_BAR; PG8_WAIT_L(0); PG8_MMA(0, 0, At, B0); PG8_BAR; PG8_SCHED;
            PG8_LDB(B1, 1, 1); PG8_STAGE(PG8_SB(1, 0), b3, voffB);
            PG8_BAR; PG8_WAIT_L(0); PG8_MMA(0, 1, At, B1); PG8_BAR;
            PG8_LDA(At, 1, 1); PG8_STAGE(PG8_SA(1, 0), a3, voffA);
            PG8_BAR; PG8_WAIT_L(0); PG8_MMA(1, 0, At, B0); PG8_BAR; PG8_SCHED;
            PG8_STAGE(PG8_SB(1, 1), b3 + hstep, voffB);
            PG8_WAIT_V(6); PG8_BAR; PG8_MMA(1, 1, At, B1); PG8_BAR;
            }
        }
        if constexpr (ALIGN_EPI) { if (wr == 0) PG8_BAR; }
        if constexpr (!Epi::AFTER_DRAIN) { E(acc, cur, wr, wc, fr, fq); S.done(cur); }
        if (!has_next) break;
#pragma unroll
        for (int a = 0; a < 2; ++a)
#pragma unroll
            for (int b = 0; b < 2; ++b)
#pragma unroll
                for (int m = 0; m < 4; ++m)
#pragma unroll
                    for (int n = 0; n < 2; ++n) acc[a][b][m][n] = (f32x4){0.f, 0.f, 0.f, 0.f};
        cur = nxt; cA = nA; cB = nB; ++ui;
        if constexpr (ALIGN_EPI) { if (wr == 1) PG8_BAR; }
    }
    PG8_WAIT_V(0);
    if constexpr (!ALIGN_EPI) { if (wr == 0) PG8_BAR; }
    PG8_BAR;
    if constexpr (Epi::AFTER_DRAIN) { E.fused(acc, cur, wr, wc, fr, fq, lds, wid, lane); S.done(cur); }
#undef PG8_SA
#undef PG8_SB
#undef PG8_STAGE
#undef PG8_LDA
#undef PG8_LDB
#undef PG8_MMA
#undef PG8_WAIT_V
#undef PG8_WAIT_L
#undef PG8_BAR
#undef PG8_SCHED
}
}
#define GAS __attribute__((address_space(1)))
#define LAS __attribute__((address_space(3)))
typedef unsigned short bf16;
typedef unsigned v4u __attribute__((ext_vector_type(4)));
typedef float f32x4 __attribute__((ext_vector_type(4)));
typedef short bf16x8 __attribute__((ext_vector_type(8)));
typedef GAS unsigned gu32;
typedef GAS unsigned long long gu64;
#define RLX_AGENT __ATOMIC_RELAXED, __HIP_MEMORY_SCOPE_AGENT
#define LDS_WAIT() asm volatile("s_waitcnt lgkmcnt(0)" ::: "memory")
#define VM_WAIT() asm volatile("s_waitcnt vmcnt(0)" ::: "memory")
__device__ __forceinline__ unsigned long long rt() { return __builtin_amdgcn_s_memrealtime(); }
__device__ __forceinline__ unsigned f2bf(float f) { unsigned u = __builtin_bit_cast(unsigned, f); return (u + 0x7fffu + ((u >> 16) & 1u)) >> 16; }
__device__ __forceinline__ unsigned pk2(float lo, float hi) { return f2bf(lo) | (f2bf(hi) << 16); }

#define XB_TMO      128
#define XB_XCNT(j)  (256  + 64 * (j))
#define XB_XSUB(j)  (1280 + 64 * (j))
#define XB_XGEN(j)  (2304 + 64 * (j))
#define XB_TOP      3328
#define XB_TOPGEN   3392
#define XCD_BAR_WORDS 3456
#define XB_SPIN_CAP (1u << 18)

__device__ __forceinline__ unsigned xb_ld(unsigned* p)              { return __hip_atomic_load(p, __ATOMIC_RELAXED, __HIP_MEMORY_SCOPE_AGENT); }
__device__ __forceinline__ unsigned xb_add(unsigned* p, unsigned v) { return __hip_atomic_fetch_add(p, v, __ATOMIC_RELAXED, __HIP_MEMORY_SCOPE_AGENT); }
__device__ __forceinline__ unsigned xb_xcc_id() { return (unsigned)__builtin_amdgcn_s_getreg((3 << 11) | 20) & 0xFu; }
#define XB_SPIN(cond, bar) do { unsigned _sp = 0; while (cond) { __builtin_amdgcn_s_sleep(1); \
    if ((++_sp & 255u) == 0u) { if (xb_ld(&(bar)[XB_TMO])) break; if (_sp > XB_SPIN_CAP) { atomicAdd(&(bar)[XB_TMO], 1u); break; } } } } while (0)

struct XcdBarrier {
    unsigned* bar; unsigned x; unsigned w;
    volatile LAS unsigned* st;
};

__device__ __forceinline__ XcdBarrier xcd_barrier_post(unsigned* bar, volatile LAS unsigned* st) {
    XcdBarrier b; b.bar = bar; b.x = xb_xcc_id(); b.st = st; b.w = (unsigned)__builtin_amdgcn_readfirstlane(threadIdx.x >> 6);
    if (threadIdx.x == 0) (void)xb_add(&bar[XB_XCNT(b.x)], 1u);
    return b;
}
__device__ __forceinline__ void xcd_barrier_complete(unsigned* bar, unsigned x, unsigned& nloc, unsigned& nx) {
    const unsigned G = gridDim.x * gridDim.y * gridDim.z;
    unsigned sum, cnt, mine, sp = 0u;
    for (;;) {
        sum = 0u; cnt = 0u; mine = 0u;
#pragma unroll
        for (unsigned j = 0; j < 16; ++j) { const unsigned c = xb_ld(&bar[XB_XCNT(j)]); sum += c; cnt += (c > 0u) ? 1u : 0u; mine = (j == x) ? c : mine; }
        if (sum == G) break;
        __builtin_amdgcn_s_sleep(1);
        if ((++sp & 255u) == 0u) { if (xb_ld(&bar[XB_TMO])) break; if (sp > XB_SPIN_CAP) { atomicAdd(&bar[XB_TMO], 1u); break; } }
    }
    nloc = mine > 0u ? mine : 1u; nx = cnt > 0u ? cnt : 1u;
}

__device__ __forceinline__ void xcd_barrier(const XcdBarrier& b) {
    asm volatile("s_waitcnt vmcnt(0)" ::: "memory");
    __syncthreads();
    unsigned lane_b; asm volatile("v_mbcnt_lo_u32_b32 %0, -1, 0\n\tv_mbcnt_hi_u32_b32 %0, -1, %0" : "=v"(lane_b));
    if (b.w == 0u && lane_b == 0u) {
        unsigned* bar = b.bar;
        __builtin_amdgcn_s_waitcnt(0);
        unsigned nloc = b.st[0], nx = b.st[1];
        if (nloc == 0u) { xcd_barrier_complete(bar, b.x, nloc, nx); b.st[0] = nloc; b.st[1] = nx; }
        const unsigned old = xb_add(&bar[XB_XSUB(b.x)], 1u);
        const unsigned gen = old / nloc;
        if (old + 1u == (gen + 1u) * nloc) {
            __builtin_amdgcn_fence(__ATOMIC_RELEASE, "agent");
            asm volatile("s_waitcnt vmcnt(0)" ::: "memory");
            const unsigned og = xb_add(&bar[XB_TOP], 1u);
            const unsigned tg = og / nx;
            if (og + 1u == (tg + 1u) * nx) xb_add(&bar[XB_TOPGEN], 1u);
            else XB_SPIN(xb_ld(&bar[XB_TOPGEN]) == tg, bar);
            __builtin_amdgcn_fence(__ATOMIC_ACQUIRE, "agent");
            xb_add(&bar[XB_XGEN(b.x)], 1u);
            asm volatile("s_waitcnt vmcnt(0)" ::: "memory");
        } else {
            XB_SPIN(xb_ld(&bar[XB_XGEN(b.x)]) == gen, bar);
            __builtin_amdgcn_fence(__ATOMIC_ACQUIRE, "agent");
            asm volatile("s_waitcnt vmcnt(0)" ::: "memory");
        }
    }
    __syncthreads();
}
#ifndef G_SP2
#define G_SP2 true
#endif
#ifndef G_ALIGN
#define G_ALIGN true
#endif
#ifndef REP3A
#define REP3A 1
#endif
#ifndef REP2B
#define REP2B 1
#endif
#ifndef REP2A
#define REP2A 1
#endif
#ifndef REP6
#define REP6 1
#endif
#ifndef REP5
#define REP5 1
#endif
#ifndef REP0A
#define REP0A 1
#endif
#ifndef REP0B
#define REP0B 1
#endif
#ifndef REP0
#define REP0 1
#endif
#ifndef REP1
#define REP1 1
#endif
#ifndef REP2
#define REP2 1
#endif
#ifndef REP3
#define REP3 1
#endif
#ifndef REP4
#define REP4 1
#endif
constexpr int NWAVES = 8;
constexpr int BATCH = 4, SEQ = 4096, DM = 2048, M = BATCH * SEQ;
constexpr int PLE = 256;
constexpr int GH = 4, GDK = 128, GDV = 256, GRANK = 16;
constexpr int SH = 8, SDH = 128;
constexpr int DIN_SRC = 7184;
constexpr int LDU = 7168;
constexpr int UQ = 0, UK = 512, UV = 1024, UG = 2048, USQ = 3072, USK = 4096, USV = 5120, USG = 6144;
constexpr float EPS = 1e-6f;
constexpr float SB_T = 30.0f;

constexpr size_t MiB = 1u << 20;
constexpr size_t WS_CTL = 0, CTL_ZERO_BYTES = 1 * MiB;
constexpr size_t WS_WIN = 2 * MiB, WS_WOUT = 30 * MiB, WS_WG = 38 * MiB, WS_WP = 46 * MiB;
constexpr size_t WS_RS = 47 * MiB, WS_GLR = 48 * MiB, WS_PIN = 50 * MiB;
constexpr size_t WS_BDEC = 480 * MiB;
constexpr size_t WS_XB = 64 * MiB;
constexpr size_t WS_U = 128 * MiB;
constexpr size_t WS_PB = 128 * MiB;
constexpr size_t WS_MIX = 192 * MiB;
constexpr size_t WS_HRES = 352 * MiB;
constexpr size_t WS_MIXIN = 352 * MiB;
constexpr size_t WS_DS = 416 * MiB, WS_SIN = 448 * MiB, WS_GS = 58 * MiB;
constexpr size_t WS_END = 512 * MiB;
constexpr int CW_BAR = 4096;

constexpr int RING_OFF = 0, RING_BYTES = 131072;
constexpr int LDSCTL_OFF = 152064, MISC_OFF = LDSCTL_OFF + 320;
constexpr int LDS_BYTES = 153600;
constexpr int P0_TAB_OFF = 69632, P0_PART_OFF = 135168;

struct Frame {
    LAS unsigned char* lds;
    volatile LAS unsigned* MISC;
    gu32* ctl;
    int vcu, G, wave;
};
#define F_WAVE F.wave
#define PHASE_IDS() int lane_o; asm volatile("v_mbcnt_lo_u32_b32 %0, -1, 0\n\tv_mbcnt_hi_u32_b32 %0, -1, %0" : "=v"(lane_o)); \
    const int lane = lane_o, wave = F_WAVE, tid = wave * 64 + lane; (void)tid; (void)lane; (void)wave
__device__ __forceinline__ float wave_sum(float v) {
#pragma unroll
    for (int o = 1; o < 64; o <<= 1) v += __shfl_xor(v, o);
    return v;
}
__device__ __forceinline__ float bf_lo(unsigned w) { return __uint_as_float(w << 16); }
__device__ __forceinline__ float bf_hi(unsigned w) { return __uint_as_float(w & 0xffff0000u); }
__device__ __forceinline__ float bf2f(bf16 b) { return __uint_as_float(((unsigned)b) << 16); }

__device__ __forceinline__ void p0_item64(const float* W, int ldw, int K, bf16* WT, int src_col0, int dst_col0, int k0, const float* gk, LAS float* scr, int lane) {
#pragma unroll 8
    for (int i = 0; i < 16; ++i) { const int kk = 4 * i + (lane >> 4), c4 = 4 * (lane & 15);
        f32x4 v = *(const GAS f32x4*)(W + (size_t)(k0 + kk) * ldw + src_col0 + c4); if (gk) { const float g = gk[k0 + kk]; v = v * g; }
        LAS float* d = scr + kk * 65 + c4; d[0] = v.x; d[1] = v.y; d[2] = v.z; d[3] = v.w; }
    LDS_WAIT(); asm volatile("" ::: "memory");
    const int c = lane & 7, tile0 = dst_col0 & ~255, wc = (dst_col0 >> 6) & 3;
#pragma unroll
    for (int j = 0; j < 8; ++j) { const int r64 = 8 * j + (lane >> 3), bj = r64 >> 5, rho = r64 & 31, csrc = r64;
        const LAS float* s = scr + (8 * c) * 65 + csrc;
        v4u o; o.x = pk2(s[0 * 65], s[1 * 65]); o.y = pk2(s[2 * 65], s[3 * 65]); o.z = pk2(s[4 * 65], s[5 * 65]); o.w = pk2(s[6 * 65], s[7 * 65]);
        *(GAS v4u*)(WT + (size_t)(tile0 + 128 * bj + 32 * wc + rho) * K + k0 + 8 * c) = o; }
    LDS_WAIT(); asm volatile("" ::: "memory");
}

struct Args { const float* in[12]; float* out; unsigned char* ws; };
typedef short v4i16_t __attribute__((ext_vector_type(4)));
namespace gla {
typedef short s16x4 __attribute__((ext_vector_type(4)));
typedef float f32x16 __attribute__((ext_vector_type(16)));
typedef float f32x2_t __attribute__((ext_vector_type(2)));
typedef __bf16 bf16x2_t __attribute__((ext_vector_type(2)));
constexpr int L_Q = 0, L_K = 16384, L_L = 32768, L_V = 49152, L_O = 81920, L_TOT = 147456, L_GC = 151552, L_END = 152064;
constexpr float L2E = 1.4426950408889634f;
__device__ __forceinline__ unsigned off_b(unsigned row, unsigned ch) { return 256u * row + 16u * (ch ^ (((row & 3u) << 2) | ((row >> 2) & 3u))); }
__device__ __forceinline__ int crow(int i, int hh) { return (i & 3) + 8 * (i >> 2) + 4 * hh; }
__device__ __forceinline__ unsigned cvtpk(float lo, float hi) { f32x2_t v = {lo, hi}; bf16x2_t b = __builtin_convertvector(v, bf16x2_t); return __builtin_bit_cast(unsigned, b); }
__device__ __forceinline__ s16x4 vtr(LAS const unsigned char* p) { return __builtin_bit_cast(s16x4, __builtin_amdgcn_ds_read_tr16_b64_v4i16((LAS v4i16_t*)p)); }
__device__ __forceinline__ bf16x8 tr_frag(LAS const unsigned char* img, int lane, int c, int ks) {
    const unsigned hh = lane >> 5, blk = (lane >> 4) & 1, q = (lane & 15) >> 2, p = lane & 3;
    const unsigned ch = 4u * c + 2u * blk + (p >> 1);
    const unsigned r0 = 16u * ks + 4u * hh + q, r1 = r0 + 8u;
    const s16x4 lo = vtr(img + off_b(r0, ch) + 8u * (p & 1)), hi = vtr(img + off_b(r1, ch) + 8u * (p & 1));
    return __builtin_shufflevector(lo, hi, 0, 1, 2, 3, 4, 5, 6, 7);
}
__device__ __forceinline__ bf16x8 row_frag(LAS const unsigned char* img, int row, int s, int hh) { return *(const LAS bf16x8*)(img + off_b(row, 2 * s + hh)); }
__device__ __forceinline__ bf16x8 pack8(const f32x16& x, int s) {
    v4u p; p.x = cvtpk(x[8 * s + 0], x[8 * s + 1]); p.y = cvtpk(x[8 * s + 2], x[8 * s + 3]); p.z = cvtpk(x[8 * s + 4], x[8 * s + 5]); p.w = cvtpk(x[8 * s + 6], x[8 * s + 7]);
    return __builtin_bit_cast(bf16x8, p);
}
#define GLA_MFMA(a, b, c) __builtin_amdgcn_mfma_f32_32x32x16_bf16((a), (b), (c), 0, 0, 0)
#define GLA_BAR() asm volatile("s_waitcnt lgkmcnt(0)\n\ts_barrier" ::: "memory")

template <int PASS  >
__device__ __forceinline__ void item(Frame& F, const Args& A, int it) {
    PHASE_IDS();
    LAS unsigned char* lds = F.lds;
    const float* w_a2 = A.in[4]; const float* b_a = A.in[5]; const float* g_head = A.in[6];
    const bf16* U = (const bf16*)(A.ws + WS_U); const float* GLR = (const float*)(A.ws + WS_GLR); bf16* MIXIN = (bf16*)(A.ws + WS_MIXIN);
    float* BDEC = (float*)(A.ws + WS_BDEC);
    float* DS = (float*)(A.ws + WS_DS); float* SIN = (float*)(A.ws + WS_SIN); float* GS = (float*)(A.ws + WS_GS);
    const int sc = it & 15, h = (it >> 4) & 3, b = it >> 6;
    const int hh0 = lane >> 5, r320 = lane & 31; int lane_s = lane;
    LAS unsigned char* imgQ = lds + L_Q; LAS unsigned char* imgK = lds + L_K; LAS unsigned char* imgL = lds + L_L; LAS unsigned char* imgV = lds + L_V;
    LAS float* Ot = (LAS float*)(lds + L_O); LAS float* tot = (LAS float*)(lds + L_TOT); LAS float* gc = (LAS float*)(lds + L_GC);
    f32x16 St[4];
#pragma unroll
    for (int db = 0; db < 4; ++db)
#pragma unroll
        for (int i = 0; i < 16; ++i) St[db][i] = PASS ? SIN[(size_t)it * 32768 + (size_t)(32 * db + crow(i, hh0)) * 256 + 32 * wave + r320] : 0.f;
    float blsum[2] = {0.f, 0.f};
    float g0, g1; unsigned kv[8], qv[8]; unsigned long long gpre[8]; f32x2_t bd[8], ball;
#define GLA_LOAD_QK(mm) do { const size_t mq_ = (mm); if (!PASS) { g0 = GLR[(mq_ + 8 * wave) * 16 + lane]; g1 = GLR[(mq_ + 8 * wave) * 16 + 64 + lane]; }     \
        _Pragma("unroll") for (int i = 0; i < 8; ++i) { kv[i] = *(const GAS unsigned*)(U + (mq_ + 8 * wave + i) * LDU + UK + h * 128 + 2 * lane); \
            if (PASS) qv[i] = *(const GAS unsigned*)(U + (mq_ + 8 * wave + i) * LDU + UQ + h * 128 + 2 * lane); } } while (0)
#define GLA_LOAD_B(mm) do { const size_t mb_ = (mm); ball = *(const GAS f32x2_t*)(BDEC + (mb_ + 63) * 512 + h * 128 + 2 * lane); \
        _Pragma("unroll") for (int i = 0; i < 8; ++i) bd[i] = *(const GAS f32x2_t*)(BDEC + (mb_ + 8 * wave + i) * 512 + h * 128 + 2 * lane); } while (0)
#define GLA_LOAD_V(mm) do { const size_t mv_ = (mm); _Pragma("unroll") for (int j = 0; j < 4; ++j) { const int pidx = 4 * wave + j, eh = pidx >> 4, rg = pidx & 15; \
            const unsigned row = 4u * rg + ((unsigned)lane >> 4), ch = ((unsigned)lane & 15u) ^ (((row & 3u) << 2) | ((row >> 2) & 3u)); \
            __builtin_amdgcn_global_load_lds((const GAS unsigned*)(U + (mv_ + row) * LDU + UV + h * 256 + eh * 128 + 8 * ch), (LAS unsigned*)(imgV + eh * 16384 + 1024 * rg), 16, 0, 0); } } while (0)
    { const size_t mf = (size_t)b * SEQ + sc * 256; GLA_LOAD_QK(mf); GLA_LOAD_V(mf); if (PASS) GLA_LOAD_B(mf); }
    for (int c4 = 0; c4 < 4; ++c4) {
        const size_t m0 = (size_t)b * SEQ + sc * 256 + c4 * 64;
        { int l1 = lane_o; asm volatile("" : "+v"(l1)); lane_s = l1; }
#define lane lane_s
#define tid (wave * 64 + lane_s)
        const unsigned d0 = 2u * lane, pq = (d0 & ~12u) | ((d0 & 4u) << 1) | ((d0 & 8u) >> 1);
        float cs[8][2]; float pref[2] = {0.f, 0.f}, all[2] = {0.f, 0.f};
        if (!PASS) {
        const GAS float* w_a2o = (const GAS float*)w_a2; asm volatile("" : "+s"(w_a2o));
        float wa[2][16], ba[2];
#pragma unroll
        for (int c = 0; c < 2; ++c) { ba[c] = b_a[h * 128 + 2 * lane + c];
#pragma unroll
            for (int r = 0; r < 16; ++r) wa[c][r] = w_a2o[r * 512 + h * 128 + 2 * lane + c]; }
#pragma unroll
        for (int i = 0; i < 8; ++i) {
            float pre0 = ba[0], pre1 = ba[1];
#pragma unroll
            for (int r = 0; r < 16; ++r) { const float g = __uint_as_float((unsigned)__builtin_amdgcn_readlane((int)__float_as_uint(i < 4 ? g0 : g1), (i & 3) * 16 + r)); pre0 += g * wa[0][r]; pre1 += g * wa[1][r]; }
            const float l0 = (fminf(pre0, 0.f) * L2E - __builtin_amdgcn_logf(1.0f + __builtin_amdgcn_exp2f(-fabsf(pre0) * L2E))) * (1.0f / 16.0f);
            const float l1 = (fminf(pre1, 0.f) * L2E - __builtin_amdgcn_logf(1.0f + __builtin_amdgcn_exp2f(-fabsf(pre1) * L2E))) * (1.0f / 16.0f);
            cs[i][0] = (i ? cs[i - 1][0] : 0.f) + l0; cs[i][1] = (i ? cs[i - 1][1] : 0.f) + l1;
        }
        *(LAS f32x2_t*)(tot + wave * 128 + 2 * lane) = (f32x2_t){cs[7][0], cs[7][1]};
        GLA_BAR();
#pragma unroll
        for (int w2 = 0; w2 < 8; ++w2) { const f32x2_t tv = *(const LAS f32x2_t*)(tot + w2 * 128 + 2 * lane); all[0] += tv.x; all[1] += tv.y; if (w2 < wave) { pref[0] += tv.x; pref[1] += tv.y; } }
#pragma unroll
        for (int i = 0; i < 8; ++i) *(GAS f32x2_t*)(BDEC + (m0 + 8 * wave + i) * 512 + h * 128 + 2 * lane) = (f32x2_t){pref[0] + cs[i][0], pref[1] + cs[i][1]};
        } else {
#pragma unroll
            for (int i = 0; i < 8; ++i) { cs[i][0] = bd[i].x; cs[i][1] = bd[i].y; }
            all[0] = ball.x; all[1] = ball.y;
        }
        const float gl0 = __builtin_amdgcn_exp2f(all[0]), gl1 = __builtin_amdgcn_exp2f(all[1]);
        blsum[0] += all[0]; blsum[1] += all[1];
        if (wave == 0) *(LAS f32x2_t*)(gc + 2 * lane) = (f32x2_t){gl0, gl1};
#pragma unroll
        for (int i = 0; i < 8; ++i) {
            const int t = 8 * wave + i;
            const float b0 = pref[0] + cs[i][0], b1 = pref[1] + cs[i][1];
            const float en0 = __builtin_amdgcn_exp2f(-b0), en1 = __builtin_amdgcn_exp2f(-b1);
            const float k0 = bf_lo(kv[i]), k1 = bf_hi(kv[i]);
            *(LAS unsigned*)(imgL + off_b(t, d0 >> 3) + (d0 & 7u) * 2u) = cvtpk(k0 * (en0 * gl0), k1 * (en1 * gl1));
            if (PASS) {
                const float eb0 = __builtin_amdgcn_exp2f(b0), eb1 = __builtin_amdgcn_exp2f(b1);
                const float q0 = bf_lo(qv[i]) * 0.08838834764831845f, q1 = bf_hi(qv[i]) * 0.08838834764831845f;
                *(LAS unsigned*)(imgK + off_b(t, pq >> 3) + (pq & 7u) * 2u) = cvtpk(k0 * en0, k1 * en1);
                *(LAS unsigned*)(imgQ + off_b(t, pq >> 3) + (pq & 7u) * 2u) = cvtpk(q0 * eb0, q1 * eb1);
            }
        }
        asm volatile("s_waitcnt vmcnt(0)" ::: "memory"); GLA_BAR();
        { int l2 = lane_o; asm volatile("" : "+v"(l2)); lane_s = l2; }
        const int hh = lane >> 5, r32 = lane & 31;
        if (c4 < 3) GLA_LOAD_QK(m0 + 64);
        LAS const unsigned char* myV = imgV + (wave >> 2) * 16384;
        bf16x8 Vf[4];
#pragma unroll
        for (int ks = 0; ks < 4; ++ks) Vf[ks] = tr_frag(myV, lane, wave & 3, ks);
        if (PASS) {
            bf16x8 SP[4][2];
#pragma unroll
            for (int db = 0; db < 4; ++db) { SP[db][0] = pack8(St[db], 0); SP[db][1] = pack8(St[db], 1); }
#pragma unroll
            for (int tb = 0; tb < 2; ++tb) {
                bf16x8 Qf[8];
#pragma unroll
                for (int s = 0; s < 8; ++s) Qf[s] = row_frag(imgQ, 32 * tb + r32, s, hh);
                f32x16 o;
#pragma unroll
                for (int i = 0; i < 16; ++i) o[i] = 0.f;
#pragma unroll
                for (int db = 0; db < 4; ++db) { o = GLA_MFMA(Qf[2 * db], SP[db][0], o); o = GLA_MFMA(Qf[2 * db + 1], SP[db][1], o); }
#pragma unroll
                for (int tb2 = 0; tb2 <= tb; ++tb2) {
                    f32x16 pt;
#pragma unroll
                    for (int i = 0; i < 16; ++i) pt[i] = 0.f;
#pragma unroll
                    for (int s = 0; s < 8; ++s) pt = GLA_MFMA(row_frag(imgK, 32 * tb2 + r32, s, hh), Qf[s], pt);
                    if (tb2 == tb) {
#pragma unroll
                        for (int i = 0; i < 16; ++i) pt[i] = (crow(i, hh) <= r32) ? pt[i] : 0.f;
                    }
                    o = GLA_MFMA(pack8(pt, 0), Vf[2 * tb2], o); o = GLA_MFMA(pack8(pt, 1), Vf[2 * tb2 + 1], o);
                }
#pragma unroll
                for (int i = 0; i < 16; ++i) Ot[(32 * tb + crow(i, hh)) * 256 + 32 * wave + r32] = o[i];
            }
        }
#pragma unroll
        for (int db = 0; db < 4; ++db) {
#pragma unroll
            for (int g4 = 0; g4 < 4; ++g4) { const f32x4 gv = *(const LAS f32x4*)(gc + 32 * db + 8 * g4 + 4 * hh);
                St[db][4 * g4 + 0] *= gv.x; St[db][4 * g4 + 1] *= gv.y; St[db][4 * g4 + 2] *= gv.z; St[db][4 * g4 + 3] *= gv.w; }
#pragma unroll
            for (int ks = 0; ks < 4; ++ks) St[db] = GLA_MFMA(tr_frag(imgL, lane, db, ks), Vf[ks], St[db]);
        }
        GLA_BAR();
        { int l3 = lane_o; asm volatile("" : "+v"(l3)); lane_s = l3; }
        if (PASS) {
#pragma unroll
            for (int rr = 0; rr < 8; ++rr) gpre[rr] = *(const GAS unsigned long long*)(U + (m0 + 8 * wave + rr) * LDU + UG + h * 256 + 4 * lane);
        }
        if (c4 < 3) { GLA_LOAD_V(m0 + 64); if (PASS) GLA_LOAD_B(m0 + 64); }
        if (PASS) {
            const f32x4 gh = *(const GAS f32x4*)(g_head + 4 * lane);
#pragma unroll
            for (int rr = 0; rr < 8; ++rr) { const int t = 8 * wave + rr;
                const f32x4 ov = *(const LAS f32x4*)(Ot + t * 256 + 4 * lane);
                float ss = (ov.x * ov.x + ov.y * ov.y) + (ov.z * ov.z + ov.w * ov.w);
                ss = wave_sum(ss); const float rn = 1.0f / sqrtf(ss * (1.0f / 256.0f) + EPS);
                const unsigned long long gw = gpre[rr];
                const float ga = bf_lo((unsigned)gw), gb = bf_hi((unsigned)gw), gcc = bf_lo((unsigned)(gw >> 32)), gd = bf_hi((unsigned)(gw >> 32));
                const float v0 = ov.x * rn * gh.x * (ga / (1.0f + __expf(-ga))), v1 = ov.y * rn * gh.y * (gb / (1.0f + __expf(-gb)));
                const float v2 = ov.z * rn * gh.z * (gcc / (1.0f + __expf(-gcc))), v3 = ov.w * rn * gh.w * (gd / (1.0f + __expf(-gd)));
                *(GAS unsigned long long*)(MIXIN + (m0 + t) * DM + h * 256 + 4 * lane) = (unsigned long long)cvtpk(v0, v1) | ((unsigned long long)cvtpk(v2, v3) << 32);
                if (rr & 1) asm volatile("" ::: "memory"); }
        }
    }
#undef lane
#undef tid
#undef GLA_LOAD_QK
#undef GLA_LOAD_V
#undef GLA_LOAD_B
    if (!PASS) {
#pragma unroll
        for (int db = 0; db < 4; ++db)
#pragma unroll
            for (int i = 0; i < 16; ++i) DS[(size_t)it * 32768 + (size_t)(32 * db + crow(i, hh0)) * 256 + 32 * wave + r320] = St[db][i];
        if (wave == 0) *(GAS f32x2_t*)(GS + (size_t)it * 128 + 2 * lane) = (f32x2_t){__builtin_amdgcn_exp2f(blsum[0]), __builtin_amdgcn_exp2f(blsum[1])};
    }
    __syncthreads();
}
__device__ __forceinline__ void scan(Frame& F, const Args& A) {
    PHASE_IDS();
    const int gtid = (int)blockIdx.x * (NWAVES * 64) + tid, nthreads = F.G * NWAVES * 64;
    const float* DS = (const float*)(A.ws + WS_DS); float* SIN = (float*)(A.ws + WS_SIN); const float* GS = (const float*)(A.ws + WS_GS);
    for (int idx = gtid; idx < 16 * 8192; idx += nthreads) {
        const int bh = idx >> 13, e4 = idx & 8191, d = e4 >> 6;
        f32x4 cur = (f32x4){0.f, 0.f, 0.f, 0.f};
#pragma unroll 4
        for (int s = 0; s < 16; ++s) { const size_t itx = (size_t)bh * 16 + s;
            *((GAS f32x4*)(SIN + itx * 32768) + e4) = cur;
            if (s < 15) { const float g = GS[itx * 128 + d]; const f32x4 dv = *((const GAS f32x4*)(DS + itx * 32768) + e4); cur = cur * g + dv; } }
    }
}
}
namespace sb {
using gla::f32x16; using gla::off_b; using gla::crow; using gla::tr_frag; using gla::row_frag; using gla::pack8; using gla::L2E;
constexpr float T2 = 25.0f * 1.4426950408889634f;
__device__ __forceinline__ void wave_item(Frame& F, const Args& A, int wi) {
    PHASE_IDS();
    const bf16* U = (const bf16*)(A.ws + WS_U); bf16* MIXIN = (bf16*)(A.ws + WS_MIXIN);
    const int hh0 = lane >> 5, r320 = lane & 31;
    const int kt0 = wi & 127, h = (wi >> 7) & 7, b = wi >> 10, t0 = 32 * kt0;
    LAS unsigned char* imgK = F.lds + wave * 16384; LAS unsigned char* imgV = imgK + 8192; LAS float* Of = (LAS float*)imgK;
    const size_t rowb = (size_t)b * SEQ;
    bf16x8 Qf[8];
#pragma unroll
    for (int s = 0; s < 8; ++s) Qf[s] = *(const GAS bf16x8*)(U + (rowb + t0 + r320) * LDU + USQ + h * 128 + 16 * s + 8 * hh0);
    f32x16 o[4];
#pragma unroll
    for (int c = 0; c < 4; ++c)
#pragma unroll
        for (int i = 0; i < 16; ++i) o[c][i] = 0.f;
    float R = 0.f;
    const float C = 0.08838834764831845f * L2E;
    v4u kx[8], vx[8];
#define SB_LOADK(KT) do { const int j0_ = 32 * (KT); _Pragma("unroll") for (int i = 0; i < 8; ++i) { const int n = lane + 64 * i, row = n >> 4, ch = n & 15; \
        kx[i] = *(const GAS v4u*)(U + (rowb + j0_ + row) * LDU + USK + h * 128 + 8 * ch); } } while (0)
#define SB_LOADV(KT) do { const int j0_ = 32 * (KT); _Pragma("unroll") for (int i = 0; i < 8; ++i) { const int n = lane + 64 * i, row = n >> 4, ch = n & 15; \
        vx[i] = *(const GAS v4u*)(U + (rowb + j0_ + row) * LDU + USV + h * 128 + 8 * ch); } } while (0)
    SB_LOADK(kt0);
    int lane_t = lane;
    for (int kt = kt0; kt >= 0; --kt) {
        { int lt = lane_o; asm volatile("" : "+v"(lt)); lane_t = lt; }
#define lane lane_t
        const int hh = lane >> 5, r32 = lane & 31;
#pragma unroll
        for (int i = 0; i < 8; ++i) { const int n = lane + 64 * i, row = n >> 4, ch = n & 15; *(LAS v4u*)(imgK + off_b(row, ch)) = kx[i]; }
        SB_LOADV(kt);
        f32x16 sacc;
#pragma unroll
        for (int i = 0; i < 16; ++i) sacc[i] = 0.f;
#pragma unroll
        for (int s = 0; s < 8; ++s) sacc = GLA_MFMA(row_frag(imgK, r32, s, hh), Qf[s], sacc);
        const bool diag = (kt == kt0);
        float lk[16], G[4], Gp[4];
#pragma unroll
        for (int i = 0; i < 16; ++i) { const float z2 = sacc[i] * C; const bool act = !diag || (crow(i, hh) < r32);
            const float sp = fmaxf(z2, 0.f) + __builtin_amdgcn_logf(1.0f + __builtin_amdgcn_exp2f(-fabsf(z2)));
            lk[i] = act ? -sp : 0.f; sacc[i] = act ? z2 : -3.0e38f; }
#pragma unroll
        for (int g = 0; g < 4; ++g) { G[g] = (lk[4 * g] + lk[4 * g + 1]) + (lk[4 * g + 2] + lk[4 * g + 3]); Gp[g] = __shfl_xor(G[g], 32); }
        float acc = R;
#pragma unroll
        for (int g = 3; g >= 0; --g) {
            const float offg = acc + (hh == 0 ? Gp[g] : 0.f);
            const float r3 = offg + lk[4 * g + 3], r2 = r3 + lk[4 * g + 2], r1 = r2 + lk[4 * g + 1], r0 = r1 + lk[4 * g];
            sacc[4 * g + 3] = __builtin_amdgcn_exp2f(sacc[4 * g + 3] + r3); sacc[4 * g + 2] = __builtin_amdgcn_exp2f(sacc[4 * g + 2] + r2);
            sacc[4 * g + 1] = __builtin_amdgcn_exp2f(sacc[4 * g + 1] + r1); sacc[4 * g] = __builtin_amdgcn_exp2f(sacc[4 * g] + r0);
            acc += G[g] + Gp[g];
        }
        R = acc;
#pragma unroll
        for (int i = 0; i < 8; ++i) { const int n = lane + 64 * i, row = n >> 4, ch = n & 15; *(LAS v4u*)(imgV + off_b(row, ch)) = vx[i]; }
        if (kt > 0) SB_LOADK(kt - 1);
        const bf16x8 w0 = pack8(sacc, 0), w1 = pack8(sacc, 1);
#pragma unroll
        for (int c = 0; c < 4; ++c) { o[c] = GLA_MFMA(w0, tr_frag(imgV, lane, c, 0), o[c]); o[c] = GLA_MFMA(w1, tr_frag(imgV, lane, c, 1), o[c]); }
        if (__ballot(R > -T2) == 0ull) break;
    }
#undef lane
#undef SB_LOADK
#undef SB_LOADV
#pragma unroll
    for (int c = 0; c < 4; ++c)
#pragma unroll
        for (int i = 0; i < 16; ++i) Of[crow(i, hh0) * 128 + 32 * c + r320] = o[c][i];
#pragma unroll
    for (int pz = 0; pz < 8; ++pz) { const int row = 4 * pz + (lane >> 4), c8 = 8 * (lane & 15);
        const f32x4 a = *(const LAS f32x4*)(Of + row * 128 + c8), bq = *(const LAS f32x4*)(Of + row * 128 + c8 + 4);
        const v4u gw = *(const GAS v4u*)(U + (rowb + t0 + row) * LDU + USG + h * 128 + c8);
        const float ov[8] = {a.x, a.y, a.z, a.w, bq.x, bq.y, bq.z, bq.w}; const unsigned gws[4] = {gw.x, gw.y, gw.z, gw.w}; unsigned ow[4];
#pragma unroll
        for (int q = 0; q < 4; ++q) { const float g0 = bf_lo(gws[q]), g1 = bf_hi(gws[q]);
            ow[q] = gla::cvtpk(ov[2 * q] * (g0 / (1.0f + __expf(-g0))), ov[2 * q + 1] * (g1 / (1.0f + __expf(-g1)))); }
        v4u w; w.x = ow[0]; w.y = ow[1]; w.z = ow[2]; w.w = ow[3];
        *(GAS v4u*)(MIXIN + (rowb + t0 + row) * DM + 1024 + h * 128 + c8) = w; }
}
}

__device__ __forceinline__ void p0_prologue(Frame& F, const Args& A) {
    PHASE_IDS();
    const float* x = A.in[0]; const float* p = A.in[1]; const float* g_pre = A.in[2]; const float* w_in = A.in[3];
    const float* w_out = A.in[7]; const float* w_g = A.in[9]; const float* w_p = A.in[11];
    unsigned char* ws = A.ws;
    bf16* WinT = (bf16*)(ws + WS_WIN); bf16* WoutT = (bf16*)(ws + WS_WOUT); bf16* WgT = (bf16*)(ws + WS_WG); bf16* WpT = (bf16*)(ws + WS_WP);
    bf16* XB = (bf16*)(ws + WS_XB); bf16* PIN = (bf16*)(ws + WS_PIN); float* RS = (float*)(ws + WS_RS); float* GLR = (float*)(ws + WS_GLR);
    LAS float* scr = (LAS float*)(F.lds + RING_OFF + wave * 16640);
    const int gw = F.vcu * NWAVES + wave, NGW = F.G * NWAVES;
    for (int repa = 0; repa < REP0A; ++repa) {
    constexpr int I_IN = (DM / 64) * (LDU / 64), I_SQ = (DM / 64) * (DM / 64), I_P = (PLE / 64) * (DM / 64);
    constexpr int NITEMS = I_IN + 2 * I_SQ + I_P;
    for (int it = gw; it < NITEMS; it += NGW) {
        int r = it;
        if (r < I_IN) { const int ng = LDU / 64, kb = r / ng, g = r % ng, nd = 64 * g; p0_item64(w_in, DIN_SRC, DM, WinT, nd + (nd >= 3072 ? 16 : 0), nd, 64 * kb, g_pre, scr, lane); continue; }
        r -= I_IN;
        if (r < I_SQ) { const int ng = DM / 64, kb = r / ng, g = r % ng; p0_item64(w_out, DM, DM, WoutT, 64 * g, 64 * g, 64 * kb, nullptr, scr, lane); continue; }
        r -= I_SQ;
        if (r < I_SQ) { const int ng = DM / 64, kb = r / ng, g = r % ng; p0_item64(w_g, DM, DM, WgT, 64 * g, 64 * g, 64 * kb, nullptr, scr, lane); continue; }
        r -= I_SQ;
        { const int ng = DM / 64, kb = r / ng, g = r % ng; p0_item64(w_p, DM, PLE, WpT, 64 * g, 64 * g, 64 * kb, nullptr, scr, lane); }
    }
    for (int m = gw; m < M; m += NGW) {
        const f32x4 v = *((const GAS f32x4*)(p + (size_t)m * PLE) + lane);
        *((GAS unsigned long long*)(PIN + (size_t)m * PLE) + lane) = (unsigned long long)pk2(v.x, v.y) | ((unsigned long long)pk2(v.z, v.w) << 32);
    }
    }
    for (int repb = 0; repb < REP0B; ++repb)
    {
        LAS v4u* tab = (LAS v4u*)(F.lds + P0_TAB_OFF); LAS float* part = (LAS float*)(F.lds + P0_PART_OFF);
        __syncthreads();
        for (int e = tid; e < 64 * 64; e += NWAVES * 64) { const int kb = e >> 6, ln = e & 63, k0 = 32 * kb + 8 * (ln >> 4), n = ln & 15; float wv[8];
#pragma unroll
            for (int jj = 0; jj < 8; ++jj) wv[jj] = w_in[(size_t)(k0 + jj) * DIN_SRC + 3072 + n] * g_pre[k0 + jj];
            v4u o; o.x = pk2(wv[0], wv[1]); o.y = pk2(wv[2], wv[3]); o.z = pk2(wv[4], wv[5]); o.w = pk2(wv[6], wv[7]); tab[e] = o; }
        __syncthreads();
        for (int rb = F.vcu; rb < M / 64; rb += F.G) {
            const int rg = wave & 3, kh = wave >> 2, row = 64 * rb + 16 * rg + (lane & 15), kq = lane >> 4;
            const GAS f32x4* xr = (const GAS f32x4*)(x + (size_t)row * DM + 1024 * kh + 8 * kq);
            GAS v4u* xo = (GAS v4u*)(XB + (size_t)row * DM + 1024 * kh + 8 * kq);
            f32x4 acc = (f32x4){0.f, 0.f, 0.f, 0.f}; float ss = 0.f;
#pragma unroll 8
            for (int kb = 0; kb < 32; ++kb) {
                const f32x4 a = xr[8 * kb], c = xr[8 * kb + 1];
                ss += (a.x * a.x + a.y * a.y) + (a.z * a.z + a.w * a.w) + (c.x * c.x + c.y * c.y) + (c.z * c.z + c.w * c.w);
                v4u pa; pa.x = gla::cvtpk(a.x, a.y); pa.y = gla::cvtpk(a.z, a.w); pa.z = gla::cvtpk(c.x, c.y); pa.w = gla::cvtpk(c.z, c.w);
                xo[4 * kb] = pa;
                const v4u pb = tab[(32 * kh + kb) * 64 + lane];
                acc = __builtin_amdgcn_mfma_f32_16x16x32_bf16(__builtin_bit_cast(bf16x8, pa), __builtin_bit_cast(bf16x8, pb), acc, 0, 0, 0);
            }
            ss += __shfl_xor(ss, 16); ss += __shfl_xor(ss, 32);
            if (kh == 1) { LAS float* pp = part + (rg * 64 + lane) * 5; pp[0] = acc[0]; pp[1] = acc[1]; pp[2] = acc[2]; pp[3] = acc[3]; pp[4] = ss; }
            __syncthreads();
            if (kh == 0) { const LAS float* pp = part + (rg * 64 + lane) * 5; acc[0] += pp[0]; acc[1] += pp[1]; acc[2] += pp[2]; acc[3] += pp[3]; ss += pp[4];
                const float r = 1.0f / sqrtf(ss * (1.0f / DM) + EPS);
#pragma unroll
                for (int q = 0; q < 4; ++q) { const float rq = __shfl(r, 4 * kq + q); GLR[(size_t)(64 * rb + 16 * rg + 4 * kq + q) * 16 + (lane & 15)] = acc[q] * rq; }
                if (lane < 16) RS[64 * rb + 16 * rg + lane] = r; }
            __syncthreads();
        }
    }
}

__device__ __forceinline__ void p5_postnorm(Frame& F, const Args& A) {
    PHASE_IDS();
    const float* g_post = A.in[8]; const bf16* mixb = (const bf16*)(A.ws + WS_MIX); bf16* HB = (bf16*)(A.ws + WS_XB);
    const int gw = F.vcu * NWAVES + wave, NGW = F.G * NWAVES;
    f32x4 ga[4], gb[4];
#pragma unroll
    for (int j = 0; j < 4; ++j) { ga[j] = *((const GAS f32x4*)g_post + 2 * lane + 128 * j); gb[j] = *((const GAS f32x4*)g_post + 2 * lane + 128 * j + 1); }
    for (int m = gw; m < M; m += NGW) {
        const GAS v4u* mr = (const GAS v4u*)(mixb + (size_t)m * DM) + lane;
        GAS v4u* hr = (GAS v4u*)(HB + (size_t)m * DM) + lane;
        v4u mv[4], xv[4]; float ss = 0.f;
#pragma unroll
        for (int j = 0; j < 4; ++j) { mv[j] = mr[64 * j]; xv[j] = hr[64 * j]; }
        float mf[4][8];
#pragma unroll
        for (int j = 0; j < 4; ++j) { const unsigned w4[4] = {mv[j].x, mv[j].y, mv[j].z, mv[j].w};
#pragma unroll
            for (int q = 0; q < 4; ++q) { mf[j][2 * q] = bf_lo(w4[q]); mf[j][2 * q + 1] = bf_hi(w4[q]); ss += mf[j][2 * q] * mf[j][2 * q] + mf[j][2 * q + 1] * mf[j][2 * q + 1]; } }
        ss = wave_sum(ss); const float r = 1.0f / sqrtf(ss * (1.0f / DM) + EPS);
#pragma unroll
        for (int j = 0; j < 4; ++j) { const unsigned x4[4] = {xv[j].x, xv[j].y, xv[j].z, xv[j].w};
            v4u o; o.x = gla::cvtpk(bf_lo(x4[0]) + mf[j][0] * r * ga[j].x, bf_hi(x4[0]) + mf[j][1] * r * ga[j].y); o.y = gla::cvtpk(bf_lo(x4[1]) + mf[j][2] * r * ga[j].z, bf_hi(x4[1]) + mf[j][3] * r * ga[j].w);
            o.z = gla::cvtpk(bf_lo(x4[2]) + mf[j][4] * r * gb[j].x, bf_hi(x4[2]) + mf[j][5] * r * gb[j].y); o.w = gla::cvtpk(bf_lo(x4[3]) + mf[j][6] * r * gb[j].z, bf_hi(x4[3]) + mf[j][7] * r * gb[j].w);
            hr[64 * j] = o; }
    }
}

__global__ void __launch_bounds__(NWAVES * 64, 2) fwd_megakernel(Args args) {
    extern __shared__ __attribute__((aligned(16))) unsigned char lds[];
    Frame F;
    F.lds = (LAS unsigned char*)lds;
    F.MISC = (volatile LAS unsigned*)(F.lds + MISC_OFF);
    F.wave = __builtin_amdgcn_readfirstlane(threadIdx.x >> 6);
    F.G = gridDim.x; { const int bx = blockIdx.x; F.vcu = (F.G % 8 == 0) ? (bx % 8) * (F.G / 8) + bx / 8 : bx; }
    unsigned char* ws = args.ws;
    F.ctl = (gu32*)(ws + WS_CTL);
    for (int u = threadIdx.x; u < (LDS_BYTES - LDSCTL_OFF) / 4; u += NWAVES * 64) ((LAS unsigned*)(F.lds + LDSCTL_OFF))[u] = 0u;
    __syncthreads();
    XcdBarrier bar = xcd_barrier_post((unsigned*)(F.ctl + CW_BAR), F.MISC + 8);

    bf16* WinT = (bf16*)(ws + WS_WIN); bf16* WoutT = (bf16*)(ws + WS_WOUT); bf16* WgT = (bf16*)(ws + WS_WG); bf16* WpT = (bf16*)(ws + WS_WP);
    bf16* XB = (bf16*)(ws + WS_XB); bf16* PIN = (bf16*)(ws + WS_PIN); float* RS = (float*)(ws + WS_RS);
    bf16* U = (bf16*)(ws + WS_U); bf16* PB = (bf16*)(ws + WS_PB); bf16* MIXIN = (bf16*)(ws + WS_MIXIN);

    for (int rep = 0; rep < REP0; ++rep) {
    p0_prologue(F, args);
    xcd_barrier(bar); }
    for (int rep = 0; rep < REP1; ++rep) {
    { pg8::Gemm g{XB, WinT, M, LDU, DM}; pg8::StaticOrder S; S.init(M, LDU, F.G, (int)blockIdx.x);
      pg8::EpiB16 E{U, LDU, RS};
      pg8::gemm_phase<pg8::EpiB16, pg8::StaticOrder, G_ALIGN, G_SP2>(F.lds + RING_OFF, g, S, E, F.wave); }
    xcd_barrier(bar); }
    for (int rep = 0; rep < REP2; ++rep) {
    for (int r2 = 0; r2 < REP2A; ++r2)
    for (int it = (int)blockIdx.x; it < BATCH * GH * 16; it += F.G) gla::item<0>(F, args, it);
    { const int gw = (int)blockIdx.x * NWAVES + F.wave, NGW = F.G * NWAVES;
      for (int r2 = 0; r2 < REP2B; ++r2)
      for (int wi = gw; wi < BATCH * SH * (SEQ / 32); wi += NGW) sb::wave_item(F, args, wi); }
    xcd_barrier(bar); }
    for (int rep = 0; rep < REP3; ++rep) {
    for (int r3 = 0; r3 < REP3A; ++r3) {
    gla::scan(F, args);
    xcd_barrier(bar); }
    for (int it = (int)blockIdx.x; it < BATCH * GH * 16; it += F.G) gla::item<1>(F, args, it);
    xcd_barrier(bar); }
    for (int rep = 0; rep < REP4; ++rep) {
    { pg8::Gemm g{MIXIN, WoutT, M, DM, DM}; pg8::StaticOrder S; S.init(M, DM, F.G, (int)blockIdx.x);
      pg8::EpiB16 E{(bf16*)(ws + WS_MIX), DM, nullptr};
      pg8::gemm_phase<pg8::EpiB16, pg8::StaticOrder, G_ALIGN, G_SP2>(F.lds + RING_OFF, g, S, E, F.wave); }
    { pg8::Gemm g{PIN, WpT, M, DM, PLE}; pg8::StaticOrder S; S.init(M, DM, F.G, (int)blockIdx.x);
      pg8::EpiB16 E{PB, DM, nullptr};
      pg8::gemm_phase<pg8::EpiB16, pg8::StaticOrder, G_ALIGN, G_SP2>(F.lds + RING_OFF, g, S, E, F.wave); }
    xcd_barrier(bar); }
    for (int rep = 0; rep < REP5; ++rep) {
    p5_postnorm(F, args);
    xcd_barrier(bar); }
    for (int rep = 0; rep < REP6; ++rep)
    { pg8::Gemm g{XB, WgT, M, DM, DM}; pg8::StaticOrder S; S.init(M, DM, F.G, (int)blockIdx.x);
      pg8::EpiFinal E{XB, args.out, PB, args.in[10], DM};
      pg8::gemm_phase<pg8::EpiFinal, pg8::StaticOrder, G_ALIGN, G_SP2>(F.lds + RING_OFF, g, S, E, F.wave); }
}

extern "C" void kernel_launch(void* const* d_in, const int* in_sizes, int n_in, void* d_out, int out_size, void* d_ws, size_t ws_size, hipStream_t stream) {
    static int grid = 0;
    if (grid == 0) {
        if (n_in != 12 || in_sizes[0] != M * DM || out_size != M * DM || ws_size < WS_END) { fprintf(stderr, "kernel_launch: unexpected shapes: n_in %d in0 %d out %d ws %zu (need %zu)\n", n_in, n_in > 0 ? in_sizes[0] : -1, out_size, ws_size, (size_t)WS_END); grid = -1; return; }
        int dev = 0, cus = 0, per_cu = 0;
        if (hipGetDevice(&dev) != hipSuccess || hipDeviceGetAttribute(&cus, hipDeviceAttributeMultiprocessorCount, dev) != hipSuccess) { grid = -1; return; }
        if (hipFuncSetAttribute((const void*)fwd_megakernel, hipFuncAttributeMaxDynamicSharedMemorySize, LDS_BYTES) != hipSuccess) { fprintf(stderr, "kernel_launch: hipFuncSetAttribute failed\n"); grid = -1; return; }
        if (hipOccupancyMaxActiveBlocksPerMultiprocessor(&per_cu, (const void*)fwd_megakernel, NWAVES * 64, LDS_BYTES) != hipSuccess || per_cu < 1)
            fprintf(stderr, "kernel_launch: note: occupancy query reports %d workgroups per CU\n", per_cu);
        (void)hipGetLastError();
        grid = cus;
    }
    if (grid < 0) return;
    if (hipMemsetAsync((char*)d_ws + WS_CTL, 0, CTL_ZERO_BYTES, stream) != hipSuccess) { fprintf(stderr, "kernel_launch: hipMemsetAsync failed\n"); return; }
    Args a{};
    for (int i = 0; i < 12; ++i) a.in[i] = (const float*)d_in[i];
    a.out = (float*)d_out; a.ws = (unsigned char*)d_ws;
    hipLaunchKernelGGL(fwd_megakernel, dim3(grid), dim3(NWAVES * 64), LDS_BYTES, stream, a);
    const hipError_t le = hipPeekAtLastError();
    if (le != hipSuccess) fprintf(stderr, "kernel_launch: launch failed: %s\n", hipGetErrorName(le));
}
```

```cpp
#include <hip/hip_runtime.h>
#include <cstdio>
#include <cstdint>
namespace pg8 {
#define PG8_LAS __attribute__((address_space(3)))
typedef unsigned short bf16_t;
typedef short bf16x8 __attribute__((ext_vector_type(8)));
typedef float f32x4 __attribute__((ext_vector_type(4)));
typedef unsigned u32x4 __attribute__((ext_vector_type(4)));
constexpr int BM = 256, BK = 64, HALF = 128, HTB = HALF * BK * 2  , STAGE_BYTES = 8 * HTB, NXCD = 8, WGM = 8;

__host__ __device__ __forceinline__ int lds_byte(int r, int c) { const int st = (r >> 4) * 2 + (c >> 5), rr = r & 15, cc = c & 31, ob = rr * 64 + cc * 2; return st * 1024 + (ob ^ (((ob >> 9) & 1) << 5)); }
__host__ __device__ __forceinline__ void stage_rc(int b, int& R, int& C) { const int st = b / 1024, sb = b % 1024, swz = sb ^ (((sb >> 9) & 1) << 5); R = (st >> 1) * 16 + swz / 64; C = (st & 1) * 32 + (swz % 64) / 2; }
__host__ __device__ __forceinline__ int perm32(int rho) { const int n = rho >> 4, i = rho & 15; return 8 * (i >> 2) + 4 * n + (i & 3); }

struct Unit { int pm, pn; };
struct Gemm { const bf16_t* A; const bf16_t* Bt; int M, N, K; };

struct StaticOrder {
    int nM, nN, nwg, G, c;
    __host__ __device__ void init(int M, int N, int G_, int c_) { nM = M / BM; nN = N / BM; nwg = nM * nN; G = G_; c = c_; }
    __host__ __device__ bool next(int i, Unit& u) const {
        const long L = (long)i * G + c; if (L >= nwg) return false;
        int wgid = (int)L; { const int q = nwg / NXCD, r = nwg % NXCD, xcd = wgid % NXCD, off = wgid / NXCD; wgid = (xcd < r ? xcd * (q + 1) : r * (q + 1) + (xcd - r) * q) + off; }
        const int nig = WGM * nN, gid = wgid / nig, fm = gid * WGM, gsz = (nM - fm) < WGM ? (nM - fm) : WGM;
        u.pm = fm + ((wgid % nig) % gsz); u.pn = (wgid % nig) / gsz; return true;
    }
    __device__ __forceinline__ void a_ready(const Unit&) const {}
    __device__ __forceinline__ void done(const Unit&) const {}
};

__device__ __forceinline__ unsigned cvt_pk_bf16(float lo, float hi) { unsigned r; asm volatile("v_cvt_pk_bf16_f32 %0, %1, %2" : "=v"(r) : "v"(lo), "v"(hi)); return r; }
typedef float f32x2 __attribute__((ext_vector_type(2)));
__device__ __forceinline__ f32x2 gelu_pk(f32x2 v) {
    const f32x2 av = __builtin_elementwise_abs(v), d = av * 0.2316418882f + 1.0f;
    f32x2 t; t.x = __builtin_amdgcn_rcpf(d.x); t.y = __builtin_amdgcn_rcpf(d.y);
    f32x2 q = t * 0.5307027145f + (-0.7265760135f); q = q * t + 0.7107068705f; q = q * t + (-0.142248368f); q = q * t + 0.127414796f; q = q * t;
    const f32x2 s = (v * v) * (-0.72134752044f);
    f32x2 e; e.x = __builtin_amdgcn_exp2f(s.x); e.y = __builtin_amdgcn_exp2f(s.y);
    const f32x2 m = v * (q * e), r = v - m;
    f32x2 o; o.x = v.x < 0.f ? m.x : r.x; o.y = v.y < 0.f ? m.y : r.y; return o;
}

template <int ACT  > struct EpiBf16 {
    static constexpr bool PERM = true, AFTER_DRAIN = false; static_assert(ACT == 0 || ACT == 1, "EpiBf16: ACT is 0 (none) or 1 (gelu_pk)");
    bf16_t* O; int ldc; const float* bias; int split_cols; size_t split_stride; float scale0;
    __device__ __forceinline__ void operator()(const f32x4 (&acc)[2][2][4][2], const Unit& u, int wr, int wc, int fr, int fq) const {
        const int row0 = u.pm * BM + wr * 64 + fr; int colt = u.pn * BM; bf16_t* base = O;
        float sc = 1.f; if (split_cols) { const int t = colt / split_cols; base += (size_t)t * split_stride; colt -= t * split_cols; if (t == 0) sc = scale0; }
        const int col0 = colt + wc * 32 + 8 * fq, bcol0 = u.pn * BM + wc * 32 + 8 * fq;
        f32x4 bv[2][2];
#pragma unroll
        for (int bj = 0; bj < 2; ++bj)
#pragma unroll
            for (int n = 0; n < 2; ++n) bv[bj][n] = bias ? *(const f32x4*)(bias + bcol0 + bj * HALF + 4 * n) : (f32x4){0.f, 0.f, 0.f, 0.f};
#pragma unroll
        for (int ai = 0; ai < 2; ++ai)
#pragma unroll
            for (int m = 0; m < 4; ++m) { bf16_t* rowp = base + (size_t)(row0 + ai * HALF + m * 16) * ldc + col0;
#pragma unroll
                for (int bj = 0; bj < 2; ++bj) { f32x4 v0 = acc[ai][bj][m][0] + bv[bj][0], v1 = acc[ai][bj][m][1] + bv[bj][1];
                    if (ACT == 1) { f32x2 a = gelu_pk((f32x2){v0[0], v0[1]}), b = gelu_pk((f32x2){v0[2], v0[3]}), c = gelu_pk((f32x2){v1[0], v1[1]}), d = gelu_pk((f32x2){v1[2], v1[3]});
                        v0 = (f32x4){a.x, a.y, b.x, b.y}; v1 = (f32x4){c.x, c.y, d.x, d.y}; }
                    v0 = v0 * sc; v1 = v1 * sc; u32x4 w; w.x = cvt_pk_bf16(v0[0], v0[1]); w.y = cvt_pk_bf16(v0[2], v0[3]); w.z = cvt_pk_bf16(v1[0], v1[1]); w.w = cvt_pk_bf16(v1[2], v1[3]);
                    *(u32x4*)(rowp + bj * HALF) = w; } }
    }
};
__device__ __forceinline__ int epi_col0(const Unit& u, int wc, int fq) { return u.pn * BM + 64 * wc + 8 * fq; }
struct EpiB16 {
    static constexpr bool PERM = true, AFTER_DRAIN = false;
    bf16_t* O; int ldc; const float* rs;
    __device__ __forceinline__ void operator()(const f32x4 (&acc)[2][2][4][2], const Unit& u, int wr, int wc, int fr, int fq) const {
        const int row0 = u.pm * BM + wr * 64 + fr; const int col0 = epi_col0(u, wc, fq);
#pragma unroll
        for (int ai = 0; ai < 2; ++ai)
#pragma unroll
            for (int m = 0; m < 4; ++m) { const int row = row0 + ai * HALF + m * 16; const float sc = rs ? rs[row] : 1.0f; bf16_t* rowp = O + (size_t)row * ldc + col0;
#pragma unroll
                for (int bj = 0; bj < 2; ++bj) { const f32x4 v0 = acc[ai][bj][m][0] * sc, v1 = acc[ai][bj][m][1] * sc;
                    u32x4 w; w.x = cvt_pk_bf16(v0[0], v0[1]); w.y = cvt_pk_bf16(v0[2], v0[3]); w.z = cvt_pk_bf16(v1[0], v1[1]); w.w = cvt_pk_bf16(v1[2], v1[3]);
                    *(u32x4*)(rowp + 32 * bj) = w; } }
    }
};
struct EpiFinal {
    static constexpr bool PERM = true, AFTER_DRAIN = false;
    const bf16_t* H; float* O; const bf16_t* P; const float* bg; int ldc;
    __device__ __forceinline__ void operator()(const f32x4 (&acc)[2][2][4][2], const Unit& u, int wr, int wc, int fr, int fq) const {
        const int row0 = u.pm * BM + wr * 64 + fr, col0 = epi_col0(u, wc, fq);
        f32x4 bv[2][2];
#pragma unroll
        for (int bj = 0; bj < 2; ++bj)
#pragma unroll
            for (int n = 0; n < 2; ++n) bv[bj][n] = *(const f32x4*)(bg + col0 + 32 * bj + 4 * n);
#pragma unroll
        for (int ai = 0; ai < 2; ++ai)
#pragma unroll
            for (int m = 0; m < 4; ++m) { const size_t off = (size_t)(row0 + ai * HALF + m * 16) * ldc + col0;
#pragma unroll
                for (int bj = 0; bj < 2; ++bj) { const size_t o2 = off + 32 * bj;
                    const u32x4 hw = *(const u32x4*)(H + o2), pw = *(const u32x4*)(P + o2);
                    const unsigned hws[4] = {hw.x, hw.y, hw.z, hw.w}, pws[4] = {pw.x, pw.y, pw.z, pw.w};
#pragma unroll
                    for (int n = 0; n < 2; ++n) { const f32x4 a = acc[ai][bj][m][n] + bv[bj][n]; f32x4 o;
                        o[0] = __uint_as_float(hws[2 * n] << 16) + __uint_as_float(pws[2 * n] << 16) / (1.0f + __expf(-a[0]));
                        o[1] = __uint_as_float(hws[2 * n] & 0xffff0000u) + __uint_as_float(pws[2 * n] & 0xffff0000u) / (1.0f + __expf(-a[1]));
                        o[2] = __uint_as_float(hws[2 * n + 1] << 16) + __uint_as_float(pws[2 * n + 1] << 16) / (1.0f + __expf(-a[2]));
                        o[3] = __uint_as_float(hws[2 * n + 1] & 0xffff0000u) + __uint_as_float(pws[2 * n + 1] & 0xffff0000u) / (1.0f + __expf(-a[3]));
                        *(f32x4*)(O + o2 + 4 * n) = o; } }
                if (m & 1) asm volatile("" ::: "memory"); }
    }
};
template <class Epi, class Sched, bool ALIGN_EPI = false, bool SP2 = false>
__device__ __forceinline__ void gemm_phase(PG8_LAS unsigned char* lds, const Gemm g, const Sched& S, const Epi& E, const int wave_in  ) {
    int lane_; asm volatile("v_mbcnt_lo_u32_b32 %0, -1, 0\n\tv_mbcnt_hi_u32_b32 %0, -1, %0" : "=v"(lane_));
    const int wid = wave_in, lane = lane_, tid = wid * 64 + lane, wr = wid >> 2, wc = wid & 3, fr = lane & 15, fq = lane >> 4;
    const int K = g.K, nt = K / BK;
    unsigned voffA[2], voffB[2];
#pragma unroll
    for (int i = 0; i < 2; ++i) { int R, C; stage_rc(tid * 16 + i * 8192, R, C); const int Rb = Epi::PERM ? ((R & ~31) + perm32(R & 31)) : R;
        voffA[i] = (unsigned)(R * K + C) * 2u; voffB[i] = (unsigned)(Rb * K + C) * 2u; }
    const size_t kstep = (size_t)(BK * 2);
    const size_t hstep = (size_t)HALF * K * 2;
    const size_t tstep = 2 * hstep;
    const unsigned ldsw = (unsigned)wid * 1024u;
    const int aoff = lds_byte(wr * 64 + fr, fq * 8), boff = lds_byte(wc * 32 + fr, fq * 8);
#define PG8_SA(b, h) (((b) * 2 + (h)) * HTB)
#define PG8_SB(b, h) ((4 + (b) * 2 + (h)) * HTB)
#define PG8_STAGE(bufoff, gbase, voff) do { _Pragma("unroll") for (int _i = 0; _i < 2; ++_i) \
        __builtin_amdgcn_global_load_lds((const unsigned*)((const char*)(gbase) + (voff)[_i]), (PG8_LAS unsigned*)(lds + (bufoff) + ldsw + _i * 8192), 16, 0, 0); } while (0)
#define PG8_LDA(dst, b, h) do { _Pragma("unroll") for (int m = 0; m < 4; ++m) _Pragma("unroll") for (int k = 0; k < 2; ++k) dst[m][k] = *(const PG8_LAS bf16x8*)(lds + PG8_SA(b, h) + aoff + m * 2048 + k * 1024); } while (0)
#define PG8_LDB(dst, b, h) do { _Pragma("unroll") for (int n = 0; n < 2; ++n) _Pragma("unroll") for (int k = 0; k < 2; ++k) dst[n][k] = *(const PG8_LAS bf16x8*)(lds + PG8_SB(b, h) + boff + n * 2048 + k * 1024); } while (0)
#define PG8_MMA(ai, bj, At, Bt) do { __builtin_amdgcn_s_setprio(1); _Pragma("unroll") for (int m = 0; m < 4; ++m) _Pragma("unroll") for (int n = 0; n < 2; ++n) _Pragma("unroll") for (int k = 0; k < 2; ++k) \
        acc[ai][bj][m][n] = __builtin_amdgcn_mfma_f32_16x16x32_bf16(Bt[n][k], At[m][k], acc[ai][bj][m][n], 0, 0, 0); __builtin_amdgcn_s_setprio(0); } while (0)
#define PG8_WAIT_V(n) asm volatile("s_waitcnt vmcnt(" #n ")" ::: "memory")
#define PG8_WAIT_L(n) asm volatile("s_waitcnt lgkmcnt(" #n ")" ::: "memory")
#define PG8_BAR __builtin_amdgcn_s_barrier()
#define PG8_SCHED __builtin_amdgcn_sched_barrier(0)
    Unit cur, nxt; int ui = 0;
    if (!S.next(0, cur)) return;
    f32x4 acc[2][2][4][2];
#pragma unroll
    for (int a = 0; a < 2; ++a)
#pragma unroll
        for (int b = 0; b < 2; ++b)
#pragma unroll
            for (int m = 0; m < 4; ++m)
#pragma unroll
                for (int n = 0; n < 2; ++n) acc[a][b][m][n] = (f32x4){0.f, 0.f, 0.f, 0.f};
    bf16x8 At[4][2], B0[2][2], B1[2][2];
    const char* cA = (const char*)g.A + (size_t)cur.pm * tstep; const char* cB = (const char*)g.Bt + (size_t)cur.pn * tstep;
    S.a_ready(cur);
    if constexpr (SP2) {
        PG8_STAGE(PG8_SB(0, 0), cB, voffB); PG8_STAGE(PG8_SB(0, 1), cB + hstep, voffB); PG8_STAGE(PG8_SA(0, 0), cA, voffA); PG8_STAGE(PG8_SA(0, 1), cA + hstep, voffA);
        if (wr == 1) PG8_BAR;
        PG8_WAIT_V(2); PG8_BAR;
        PG8_STAGE(PG8_SB(1, 0), cB + kstep, voffB); PG8_STAGE(PG8_SA(1, 0), cA + kstep, voffA); PG8_STAGE(PG8_SB(1, 1), cB + hstep + kstep, voffB);
        PG8_WAIT_V(6); PG8_BAR;
    } else {
        PG8_STAGE(PG8_SB(0, 0), cB, voffB); PG8_STAGE(PG8_SA(0, 0), cA, voffA); PG8_STAGE(PG8_SB(0, 1), cB + hstep, voffB); PG8_STAGE(PG8_SA(0, 1), cA + hstep, voffA);
        if (wr == 1) PG8_BAR;
        PG8_WAIT_V(4); PG8_BAR;
        PG8_STAGE(PG8_SB(1, 0), cB + kstep, voffB); PG8_STAGE(PG8_SA(1, 0), cA + kstep, voffA); PG8_STAGE(PG8_SB(1, 1), cB + hstep + kstep, voffB);
        PG8_WAIT_V(6); PG8_BAR;
    }
    for (;;) {
        const bool has_next = S.next(ui + 1, nxt);
        const char* nA = has_next ? (const char*)g.A + (size_t)nxt.pm * tstep : cA; const char* nB = has_next ? (const char*)g.Bt + (size_t)nxt.pn * tstep : cB;
        for (int t = 0; t < nt; t += 2) {
            const bool last = (t == nt - 2);
            const char* a1 = cA + (size_t)(t + 1) * kstep;
            const char* a2 = last ? nA : cA + (size_t)(t + 2) * kstep; const char* b2 = last ? nB : cB + (size_t)(t + 2) * kstep;
            const char* a3 = a2 + kstep; const char* b3 = b2 + kstep;
            if (last && has_next) S.a_ready(nxt);
            if constexpr (SP2) {
            PG8_LDB(B0, 0, 0); PG8_LDB(B1, 0, 1); PG8_SCHED; PG8_LDA(At, 0, 0); PG8_STAGE(PG8_SA(1, 1), a1 + hstep, voffA);
            PG8_WAIT_V(8); PG8_WAIT_L(0); PG8_BAR; PG8_MMA(0, 0, At, B0); PG8_MMA(0, 1, At, B1); PG8_BAR; PG8_SCHED;
            PG8_LDA(At, 0, 1); PG8_STAGE(PG8_SB(0, 0), b2, voffB); PG8_STAGE(PG8_SB(0, 1), b2 + hstep, voffB); PG8_STAGE(PG8_SA(0, 0), a2, voffA);
            PG8_WAIT_V(8); PG8_WAIT_L(0); PG8_BAR; PG8_MMA(1, 0, At, B0); PG8_MMA(1, 1, At, B1); PG8_BAR; PG8_SCHED;
            PG8_LDB(B0, 1, 0); PG8_LDB(B1, 1, 1); PG8_SCHED; PG8_LDA(At, 1, 0); PG8_STAGE(PG8_SA(0, 1), a2 + hstep, voffA);
            PG8_WAIT_V(8); PG8_WAIT_L(0); PG8_BAR; PG8_MMA(0, 0, At, B0); PG8_MMA(0, 1, At, B1); PG8_BAR; PG8_SCHED;
            PG8_LDA(At, 1, 1); PG8_STAGE(PG8_SB(1, 0), b3, voffB); PG8_STAGE(PG8_SB(1, 1), b3 + hstep, voffB); PG8_STAGE(PG8_SA(1, 0), a3, voffA);
            PG8_WAIT_V(8); PG8_WAIT_L(0); PG8_BAR; PG8_MMA(1, 0, At, B0); PG8_MMA(1, 1, At, B1); PG8_BAR; PG8_SCHED;
            } else {
            PG8_LDB(B0, 0, 0); PG8_SCHED; PG8_LDA(At, 0, 0); PG8_STAGE(PG8_SA(1, 1), a1 + hstep, voffA);
            PG8_WAIT_L(8); PG8_BAR; PG8_WAIT_L(0); PG8_MMA(0, 0, At, B0); PG8_BAR; PG8_SCHED;
            PG8_LDB(B1, 0, 1); PG8_STAGE(PG8_SB(0, 0), b2, voffB);
            PG8_BAR; PG8_WAIT_L(0); PG8_MMA(0, 1, At, B1); PG8_BAR;
            PG8_LDA(At, 0, 1); PG8_STAGE(PG8_SA(0, 0), a2, voffA);
            PG8_BAR; PG8_WAIT_L(0); PG8_MMA(1, 0, At, B0); PG8_BAR; PG8_SCHED;
            PG8_STAGE(PG8_SB(0, 1), b2 + hstep, voffB);
            PG8_WAIT_V(6); PG8_BAR; PG8_MMA(1, 1, At, B1); PG8_BAR;
            PG8_LDB(B0, 1, 0); PG8_SCHED; PG8_LDA(At, 1, 0); PG8_STAGE(PG8_SA(0, 1), a2 + hstep, voffA);
            PG8_WAIT_L(8); PG8_BAR; PG8_WAIT_L(0); PG8_MMA(0, 0, At, B0); PG8_BAR; PG8_SCHED;
            PG8_LDB(B1, 1, 1); PG8_STAGE(PG8_SB(1, 0), b3, voffB);
            PG8_BAR; PG8_WAIT_L(0); PG8_MMA(0, 1, At, B1); PG8_BAR;
            PG8_LDA(At, 1, 1); PG8_STAGE(PG8_SA(1, 0), a3, voffA);
            PG8_BAR; PG8_WAIT_L(0); PG8_MMA(1, 0, At, B0); PG8_BAR; PG8_SCHED;
            PG8_STAGE(PG8_SB(1, 1), b3 + hstep, voffB);
            PG8_WAIT_V(6); PG8_BAR; PG8_MMA(1, 1, At, B1); PG8_BAR;
            }
        }
        if constexpr (ALIGN_EPI) { if (wr == 0) PG8_BAR; }
        if constexpr (!Epi::AFTER_DRAIN) { E(acc, cur, wr, wc, fr, fq); S.done(cur); }
        if (!has_next) break;
#pragma unroll
        for (int a = 0; a < 2; ++a)
#pragma unroll
            for (int b = 0; b < 2; ++b)
#pragma unroll
                for (int m = 0; m < 4; ++m)
#pragma unroll
                    for (int n = 0; n < 2; ++n) acc[a][b][m][n] = (f32x4){0.f, 0.f, 0.f, 0.f};
        cur = nxt; cA = nA; cB = nB; ++ui;
        if constexpr (ALIGN_EPI) { if (wr == 1) PG8_BAR; }
    }
    PG8_WAIT_V(0);
    if constexpr (!ALIGN_EPI) { if (wr == 0) PG8_BAR; }
    PG8_BAR;
    if constexpr (Epi::AFTER_DRAIN) { E.fused(acc, cur, wr, wc, fr, fq, lds, wid, lane); S.done(cur); }
#undef PG8_SA
#undef PG8_SB
#undef PG8_STAGE
#undef PG8_LDA
#undef PG8_LDB
#undef PG8_MMA
#undef PG8_WAIT_V
#undef PG8_WAIT_L
#undef PG8_BAR
#undef PG8_SCHED
}
}
#define GAS __attribute__((address_space(1)))
#define LAS __attribute__((address_space(3)))
typedef unsigned short bf16;
typedef unsigned v4u __attribute__((ext_vector_type(4)));
typedef float f32x4 __attribute__((ext_vector_type(4)));
typedef short bf16x8 __attribute__((ext_vector_type(8)));
typedef GAS unsigned gu32;
typedef GAS unsigned long long gu64;
#define RLX_AGENT __ATOMIC_RELAXED, __HIP_MEMORY_SCOPE_AGENT
#define LDS_WAIT() asm volatile("s_waitcnt lgkmcnt(0)" ::: "memory")
#define VM_WAIT() asm volatile("s_waitcnt vmcnt(0)" ::: "memory")
__device__ __forceinline__ unsigned long long rt() { return __builtin_amdgcn_s_memrealtime(); }
__device__ __forceinline__ unsigned f2bf(float f) { unsigned u = __builtin_bit_cast(unsigned, f); return (u + 0x7fffu + ((u >> 16) & 1u)) >> 16; }
__device__ __forceinline__ unsigned pk2(float lo, float hi) { return f2bf(lo) | (f2bf(hi) << 16); }

#define XB_TMO      128
#define XB_XCNT(j)  (256  + 64 * (j))
#define XB_XSUB(j)  (1280 + 64 * (j))
#define XB_XGEN(j)  (2304 + 64 * (j))
#define XB_TOP      3328
#define XB_TOPGEN   3392
#define XCD_BAR_WORDS 3456
#define XB_SPIN_CAP (1u << 18)

__device__ __forceinline__ unsigned xb_ld(unsigned* p)              { return __hip_atomic_load(p, __ATOMIC_RELAXED, __HIP_MEMORY_SCOPE_AGENT); }
__device__ __forceinline__ unsigned xb_add(unsigned* p, unsigned v) { return __hip_atomic_fetch_add(p, v, __ATOMIC_RELAXED, __HIP_MEMORY_SCOPE_AGENT); }
__device__ __forceinline__ unsigned xb_xcc_id() { return (unsigned)__builtin_amdgcn_s_getreg((3 << 11) | 20) & 0xFu; }
#define XB_SPIN(cond, bar) do { unsigned _sp = 0; while (cond) { __builtin_amdgcn_s_sleep(1); \
    if ((++_sp & 255u) == 0u) { if (xb_ld(&(bar)[XB_TMO])) break; if (_sp > XB_SPIN_CAP) { atomicAdd(&(bar)[XB_TMO], 1u); break; } } } } while (0)

struct XcdBarrier {
    unsigned* bar; unsigned x; unsigned w;
    volatile LAS unsigned* st;
};

__device__ __forceinline__ XcdBarrier xcd_barrier_post(unsigned* bar, volatile LAS unsigned* st) {
    XcdBarrier b; b.bar = bar; b.x = xb_xcc_id(); b.st = st; b.w = (unsigned)__builtin_amdgcn_readfirstlane(threadIdx.x >> 6);
    if (threadIdx.x == 0) (void)xb_add(&bar[XB_XCNT(b.x)], 1u);
    return b;
}
__device__ __forceinline__ void xcd_barrier_complete(unsigned* bar, unsigned x, unsigned& nloc, unsigned& nx) {
    const unsigned G = gridDim.x * gridDim.y * gridDim.z;
    unsigned sum, cnt, mine, sp = 0u;
    for (;;) {
        sum = 0u; cnt = 0u; mine = 0u;
#pragma unroll
        for (unsigned j = 0; j < 16; ++j) { const unsigned c = xb_ld(&bar[XB_XCNT(j)]); sum += c; cnt += (c > 0u) ? 1u : 0u; mine = (j == x) ? c : mine; }
        if (sum == G) break;
        __builtin_amdgcn_s_sleep(1);
        if ((++sp & 255u) == 0u) { if (xb_ld(&bar[XB_TMO])) break; if (sp > XB_SPIN_CAP) { atomicAdd(&bar[XB_TMO], 1u); break; } }
    }
    nloc = mine > 0u ? mine : 1u; nx = cnt > 0u ? cnt : 1u;
}

__device__ __forceinline__ void xcd_barrier(const XcdBarrier& b) {
    asm volatile("s_waitcnt vmcnt(0)" ::: "memory");
    __syncthreads();
    unsigned lane_b; asm volatile("v_mbcnt_lo_u32_b32 %0, -1, 0\n\tv_mbcnt_hi_u32_b32 %0, -1, %0" : "=v"(lane_b));
    if (b.w == 0u && lane_b == 0u) {
        unsigned* bar = b.bar;
        __builtin_amdgcn_s_waitcnt(0);
        unsigned nloc = b.st[0], nx = b.st[1];
        if (nloc == 0u) { xcd_barrier_complete(bar, b.x, nloc, nx); b.st[0] = nloc; b.st[1] = nx; }
        const unsigned old = xb_add(&bar[XB_XSUB(b.x)], 1u);
        const unsigned gen = old / nloc;
        if (old + 1u == (gen + 1u) * nloc) {
            __builtin_amdgcn_fence(__ATOMIC_RELEASE, "agent");
            asm volatile("s_waitcnt vmcnt(0)" ::: "memory");
            const unsigned og = xb_add(&bar[XB_TOP], 1u);
            const unsigned tg = og / nx;
            if (og + 1u == (tg + 1u) * nx) xb_add(&bar[XB_TOPGEN], 1u);
            else XB_SPIN(xb_ld(&bar[XB_TOPGEN]) == tg, bar);
            __builtin_amdgcn_fence(__ATOMIC_ACQUIRE, "agent");
            xb_add(&bar[XB_XGEN(b.x)], 1u);
            asm volatile("s_waitcnt vmcnt(0)" ::: "memory");
        } else {
            XB_SPIN(xb_ld(&bar[XB_XGEN(b.x)]) == gen, bar);
            __builtin_amdgcn_fence(__ATOMIC_ACQUIRE, "agent");
            asm volatile("s_waitcnt vmcnt(0)" ::: "memory");
        }
    }
    __syncthreads();
}
#ifndef G_SP2
#define G_SP2 true
#endif
#ifndef G_ALIGN
#define G_ALIGN true
#endif
#ifndef REP3A
#define REP3A 1
#endif
#ifndef REP2B
#define REP2B 1
#endif
#ifndef REP2A
#define REP2A 1
#endif
#ifndef REP6
#define REP6 1
#endif
#ifndef REP5
#define REP5 1
#endif
#ifndef REP0A
#define REP0A 1
#endif
#ifndef REP0B
#define REP0B 1
#endif
#ifndef REP0
#define REP0 1
#endif
#ifndef REP1
#define REP1 1
#endif
#ifndef REP2
#define REP2 1
#endif
#ifndef REP3
#define REP3 1
#endif
#ifndef REP4
#define REP4 1
#endif
constexpr int NWAVES = 8;
constexpr int BATCH = 4, SEQ = 4096, DM = 2048, M = BATCH * SEQ;
constexpr int PLE = 256;
constexpr int GH = 4, GDK = 128, GDV = 256, GRANK = 16;
constexpr int SH = 8, SDH = 128;
constexpr int DIN_SRC = 7184;
constexpr int LDU = 7168;
constexpr int UQ = 0, UK = 512, UV = 1024, UG = 2048, USQ = 3072, USK = 4096, USV = 5120, USG = 6144;
constexpr float EPS = 1e-6f;
constexpr float SB_T = 30.0f;

constexpr size_t MiB = 1u << 20;
constexpr size_t WS_CTL = 0, CTL_ZERO_BYTES = 1 * MiB;
constexpr size_t WS_WIN = 2 * MiB, WS_WOUT = 30 * MiB, WS_WG = 38 * MiB, WS_WP = 46 * MiB;
constexpr size_t WS_RS = 47 * MiB, WS_GLR = 48 * MiB, WS_PIN = 50 * MiB;
constexpr size_t WS_BDEC = 480 * MiB;
constexpr size_t WS_XB = 64 * MiB;
constexpr size_t WS_U = 128 * MiB;
constexpr size_t WS_PB = 128 * MiB;
constexpr size_t WS_MIX = 192 * MiB;
constexpr size_t WS_HRES = 352 * MiB;
constexpr size_t WS_MIXIN = 352 * MiB;
constexpr size_t WS_DS = 416 * MiB, WS_SIN = 448 * MiB, WS_GS = 58 * MiB;
constexpr size_t WS_END = 512 * MiB;
constexpr int CW_BAR = 4096;

constexpr int RING_OFF = 0, RING_BYTES = 131072;
constexpr int LDSCTL_OFF = 152064, MISC_OFF = LDSCTL_OFF + 320;
constexpr int LDS_BYTES = 153600;
constexpr int P0_TAB_OFF = 69632, P0_PART_OFF = 135168;

struct Frame {
    LAS unsigned char* lds;
    volatile LAS unsigned* MISC;
    gu32* ctl;
    int vcu, G, wave;
};
#define F_WAVE F.wave
#define PHASE_IDS() int lane_o; asm volatile("v_mbcnt_lo_u32_b32 %0, -1, 0\n\tv_mbcnt_hi_u32_b32 %0, -1, %0" : "=v"(lane_o)); \
    const int lane = lane_o, wave = F_WAVE, tid = wave * 64 + lane; (void)tid; (void)lane; (void)wave
__device__ __forceinline__ float wave_sum(float v) {
#pragma unroll
    for (int o = 1; o < 64; o <<= 1) v += __shfl_xor(v, o);
    return v;
}
__device__ __forceinline__ float bf_lo(unsigned w) { return __uint_as_float(w << 16); }
__device__ __forceinline__ float bf_hi(unsigned w) { return __uint_as_float(w & 0xffff0000u); }
__device__ __forceinline__ float bf2f(bf16 b) { return __uint_as_float(((unsigned)b) << 16); }

__device__ __forceinline__ void p0_item64(const float* W, int ldw, int K, bf16* WT, int src_col0, int dst_col0, int k0, const float* gk, LAS float* scr, int lane) {
#pragma unroll 8
    for (int i = 0; i < 16; ++i) { const int kk = 4 * i + (lane >> 4), c4 = 4 * (lane & 15);
        f32x4 v = *(const GAS f32x4*)(W + (size_t)(k0 + kk) * ldw + src_col0 + c4); if (gk) { const float g = gk[k0 + kk]; v = v * g; }
        LAS float* d = scr + kk * 65 + c4; d[0] = v.x; d[1] = v.y; d[2] = v.z; d[3] = v.w; }
    LDS_WAIT(); asm volatile("" ::: "memory");
    const int c = lane & 7, tile0 = dst_col0 & ~255, wc = (dst_col0 >> 6) & 3;
#pragma unroll
    for (int j = 0; j < 8; ++j) { const int r64 = 8 * j + (lane >> 3), bj = r64 >> 5, rho = r64 & 31, csrc = r64;
        const LAS float* s = scr + (8 * c) * 65 + csrc;
        v4u o; o.x = pk2(s[0 * 65], s[1 * 65]); o.y = pk2(s[2 * 65], s[3 * 65]); o.z = pk2(s[4 * 65], s[5 * 65]); o.w = pk2(s[6 * 65], s[7 * 65]);
        *(GAS v4u*)(WT + (size_t)(tile0 + 128 * bj + 32 * wc + rho) * K + k0 + 8 * c) = o; }
    LDS_WAIT(); asm volatile("" ::: "memory");
}

struct Args { const float* in[12]; float* out; unsigned char* ws; };
typedef short v4i16_t __attribute__((ext_vector_type(4)));
namespace gla {
typedef short s16x4 __attribute__((ext_vector_type(4)));
typedef float f32x16 __attribute__((ext_vector_type(16)));
typedef float f32x2_t __attribute__((ext_vector_type(2)));
typedef __bf16 bf16x2_t __attribute__((ext_vector_type(2)));
constexpr int L_Q = 0, L_K = 16384, L_L = 32768, L_V = 49152, L_O = 81920, L_TOT = 147456, L_GC = 151552, L_END = 152064;
constexpr float L2E = 1.4426950408889634f;
constexpr int OP = 264;
__device__ __forceinline__ unsigned off_b(unsigned row, unsigned ch) { return 256u * row + 16u * (ch ^ (((row & 3u) << 2) | ((row >> 2) & 3u))); }
__device__ __forceinline__ int crow(int i, int hh) { return (i & 3) + 8 * (i >> 2) + 4 * hh; }
__device__ __forceinline__ unsigned cvtpk(float lo, float hi) { f32x2_t v = {lo, hi}; bf16x2_t b = __builtin_convertvector(v, bf16x2_t); return __builtin_bit_cast(unsigned, b); }
__device__ __forceinline__ s16x4 vtr(LAS const unsigned char* p) { return __builtin_bit_cast(s16x4, __builtin_amdgcn_ds_read_tr16_b64_v4i16((LAS v4i16_t*)p)); }
__device__ __forceinline__ bf16x8 tr_frag(LAS const unsigned char* img, int lane, int c, int ks) {
    const unsigned hh = lane >> 5, blk = (lane >> 4) & 1, q = (lane & 15) >> 2, p = lane & 3;
    const unsigned ch = 4u * c + 2u * blk + (p >> 1);
    const unsigned r0 = 16u * ks + 4u * hh + q, r1 = r0 + 8u;
    const s16x4 lo = vtr(img + off_b(r0, ch) + 8u * (p & 1)), hi = vtr(img + off_b(r1, ch) + 8u * (p & 1));
    return __builtin_shufflevector(lo, hi, 0, 1, 2, 3, 4, 5, 6, 7);
}
__device__ __forceinline__ bf16x8 row_frag(LAS const unsigned char* img, int row, int s, int hh) { return *(const LAS bf16x8*)(img + off_b(row, 2 * s + hh)); }
__device__ __forceinline__ bf16x8 pack8(const f32x16& x, int s) {
    v4u p; p.x = cvtpk(x[8 * s + 0], x[8 * s + 1]); p.y = cvtpk(x[8 * s + 2], x[8 * s + 3]); p.z = cvtpk(x[8 * s + 4], x[8 * s + 5]); p.w = cvtpk(x[8 * s + 6], x[8 * s + 7]);
    return __builtin_bit_cast(bf16x8, p);
}
#define GLA_MFMA(a, b, c) __builtin_amdgcn_mfma_f32_32x32x16_bf16((a), (b), (c), 0, 0, 0)
#define GLA_BAR() asm volatile("s_waitcnt lgkmcnt(0)\n\ts_barrier" ::: "memory")

template <int PASS  >
__device__ __forceinline__ void item(Frame& F, const Args& A, int it) {
    PHASE_IDS();
    LAS unsigned char* lds = F.lds;
    const float* w_a2 = A.in[4]; const float* b_a = A.in[5]; const float* g_head = A.in[6];
    const bf16* U = (const bf16*)(A.ws + WS_U); const float* GLR = (const float*)(A.ws + WS_GLR); bf16* MIXIN = (bf16*)(A.ws + WS_MIXIN);
    float* BDEC = (float*)(A.ws + WS_BDEC);
    float* DS = (float*)(A.ws + WS_DS); float* SIN = (float*)(A.ws + WS_SIN); float* GS = (float*)(A.ws + WS_GS);
    const int sc = it & 15, h = (it >> 4) & 3, b = it >> 6;
    const int hh0 = lane >> 5, r320 = lane & 31; int lane_s = lane;
    LAS unsigned char* imgQ = lds + L_Q; LAS unsigned char* imgK = lds + L_K; LAS unsigned char* imgL = lds + L_L; LAS unsigned char* imgV = lds + L_V;
    LAS float* Ot = (LAS float*)(lds + L_O); LAS float* tot = (LAS float*)(lds + L_TOT); LAS float* gc = (LAS float*)(lds + L_GC);
    f32x16 St[4];
#pragma unroll
    for (int db = 0; db < 4; ++db)
#pragma unroll
        for (int i = 0; i < 16; ++i) St[db][i] = PASS ? SIN[(size_t)it * 32768 + (size_t)(32 * db + crow(i, hh0)) * 256 + 32 * wave + r320] : 0.f;
    float blsum[2] = {0.f, 0.f};
    float g0, g1; unsigned kv[8], qv[8]; unsigned long long gpre[8]; f32x2_t bd[8], ball;
#define GLA_LOAD_QK(mm) do { const size_t mq_ = (mm); if (!PASS) { g0 = GLR[(mq_ + 8 * wave) * 16 + lane]; g1 = GLR[(mq_ + 8 * wave) * 16 + 64 + lane]; }     \
        _Pragma("unroll") for (int i = 0; i < 8; ++i) { kv[i] = *(const GAS unsigned*)(U + (mq_ + 8 * wave + i) * LDU + UK + h * 128 + 2 * lane); \
            if (PASS) qv[i] = *(const GAS unsigned*)(U + (mq_ + 8 * wave + i) * LDU + UQ + h * 128 + 2 * lane); } } while (0)
#define GLA_LOAD_B(mm) do { const size_t mb_ = (mm); ball = *(const GAS f32x2_t*)(BDEC + (mb_ + 63) * 512 + h * 128 + 2 * lane); \
        _Pragma("unroll") for (int i = 0; i < 8; ++i) bd[i] = *(const GAS f32x2_t*)(BDEC + (mb_ + 8 * wave + i) * 512 + h * 128 + 2 * lane); } while (0)
#define GLA_LOAD_V(mm) do { const size_t mv_ = (mm); _Pragma("unroll") for (int j = 0; j < 4; ++j) { const int pidx = 4 * wave + j, eh = pidx >> 4, rg = pidx & 15; \
            const unsigned row = 4u * rg + ((unsigned)lane >> 4), ch = ((unsigned)lane & 15u) ^ (((row & 3u) << 2) | ((row >> 2) & 3u)); \
            __builtin_amdgcn_global_load_lds((const GAS unsigned*)(U + (mv_ + row) * LDU + UV + h * 256 + eh * 128 + 8 * ch), (LAS unsigned*)(imgV + eh * 16384 + 1024 * rg), 16, 0, 0); } } while (0)
    { const size_t mf = (size_t)b * SEQ + sc * 256; GLA_LOAD_QK(mf); GLA_LOAD_V(mf); if (PASS) GLA_LOAD_B(mf); }
    for (int c4 = 0; c4 < 4; ++c4) {
        const size_t m0 = (size_t)b * SEQ + sc * 256 + c4 * 64;
        { int l1 = lane_o; asm volatile("" : "+v"(l1)); lane_s = l1; }
#define lane lane_s
#define tid (wave * 64 + lane_s)
        const unsigned d0 = 2u * lane, pq = (d0 & ~12u) | ((d0 & 4u) << 1) | ((d0 & 8u) >> 1);
        float cs[8][2]; float pref[2] = {0.f, 0.f}, all[2] = {0.f, 0.f};
        if (!PASS) {
        const GAS float* w_a2o = (const GAS float*)w_a2; asm volatile("" : "+s"(w_a2o));
        float wa[2][16], ba[2];
#pragma unroll
        for (int c = 0; c < 2; ++c) { ba[c] = b_a[h * 128 + 2 * lane + c];
#pragma unroll
            for (int r = 0; r < 16; ++r) wa[c][r] = w_a2o[r * 512 + h * 128 + 2 * lane + c]; }
#pragma unroll
        for (int i = 0; i < 8; ++i) {
            float pre0 = ba[0], pre1 = ba[1];
#pragma unroll
            for (int r = 0; r < 16; ++r) { const float g = __uint_as_float((unsigned)__builtin_amdgcn_readlane((int)__float_as_uint(i < 4 ? g0 : g1), (i & 3) * 16 + r)); pre0 += g * wa[0][r]; pre1 += g * wa[1][r]; }
            const float l0 = (fminf(pre0, 0.f) * L2E - __builtin_amdgcn_logf(1.0f + __builtin_amdgcn_exp2f(-fabsf(pre0) * L2E))) * (1.0f / 16.0f);
            const float l1 = (fminf(pre1, 0.f) * L2E - __builtin_amdgcn_logf(1.0f + __builtin_amdgcn_exp2f(-fabsf(pre1) * L2E))) * (1.0f / 16.0f);
            cs[i][0] = (i ? cs[i - 1][0] : 0.f) + l0; cs[i][1] = (i ? cs[i - 1][1] : 0.f) + l1;
        }
        *(LAS f32x2_t*)(tot + wave * 128 + 2 * lane) = (f32x2_t){cs[7][0], cs[7][1]};
        GLA_BAR();
#pragma unroll
        for (int w2 = 0; w2 < 8; ++w2) { const f32x2_t tv = *(const LAS f32x2_t*)(tot + w2 * 128 + 2 * lane); all[0] += tv.x; all[1] += tv.y; if (w2 < wave) { pref[0] += tv.x; pref[1] += tv.y; } }
#pragma unroll
        for (int i = 0; i < 8; ++i) *(GAS f32x2_t*)(BDEC + (m0 + 8 * wave + i) * 512 + h * 128 + 2 * lane) = (f32x2_t){pref[0] + cs[i][0], pref[1] + cs[i][1]};
        } else {
#pragma unroll
            for (int i = 0; i < 8; ++i) { cs[i][0] = bd[i].x; cs[i][1] = bd[i].y; }
            all[0] = ball.x; all[1] = ball.y;
        }
        const float gl0 = __builtin_amdgcn_exp2f(all[0]), gl1 = __builtin_amdgcn_exp2f(all[1]);
        blsum[0] += all[0]; blsum[1] += all[1];
        if (wave == 0) *(LAS f32x2_t*)(gc + 2 * lane) = (f32x2_t){gl0, gl1};
#pragma unroll
        for (int i = 0; i < 8; ++i) {
            const int t = 8 * wave + i;
            const float b0 = pref[0] + cs[i][0], b1 = pref[1] + cs[i][1];
            const float en0 = __builtin_amdgcn_exp2f(-b0), en1 = __builtin_amdgcn_exp2f(-b1);
            const float k0 = bf_lo(kv[i]), k1 = bf_hi(kv[i]);
            *(LAS unsigned*)(imgL + off_b(t, d0 >> 3) + (d0 & 7u) * 2u) = cvtpk(k0 * (en0 * gl0), k1 * (en1 * gl1));
            if (PASS) {
                const float eb0 = __builtin_amdgcn_exp2f(b0), eb1 = __builtin_amdgcn_exp2f(b1);
                const float q0 = bf_lo(qv[i]) * 0.08838834764831845f, q1 = bf_hi(qv[i]) * 0.08838834764831845f;
                *(LAS unsigned*)(imgK + off_b(t, pq >> 3) + (pq & 7u) * 2u) = cvtpk(k0 * en0, k1 * en1);
                *(LAS unsigned*)(imgQ + off_b(t, pq >> 3) + (pq & 7u) * 2u) = cvtpk(q0 * eb0, q1 * eb1);
            }
        }
        asm volatile("s_waitcnt vmcnt(0)" ::: "memory"); GLA_BAR();
        { int l2 = lane_o; asm volatile("" : "+v"(l2)); lane_s = l2; }
        const int hh = lane >> 5, r32 = lane & 31;
        if (c4 < 3) GLA_LOAD_QK(m0 + 64);
        LAS const unsigned char* myV = imgV + (wave >> 2) * 16384;
        bf16x8 Vf[4];
#pragma unroll
        for (int ks = 0; ks < 4; ++ks) Vf[ks] = tr_frag(myV, lane, wave & 3, ks);
        if (PASS) {
            bf16x8 SP[4][2];
#pragma unroll
            for (int db = 0; db < 4; ++db) { SP[db][0] = pack8(St[db], 0); SP[db][1] = pack8(St[db], 1); }
#pragma unroll
            for (int tb = 0; tb < 2; ++tb) {
                bf16x8 Qf[8];
#pragma unroll
                for (int s = 0; s < 8; ++s) Qf[s] = row_frag(imgQ, 32 * tb + r32, s, hh);
                f32x16 o;
#pragma unroll
                for (int i = 0; i < 16; ++i) o[i] = 0.f;
#pragma unroll
                for (int db = 0; db < 4; ++db) { o = GLA_MFMA(Qf[2 * db], SP[db][0], o); o = GLA_MFMA(Qf[2 * db + 1], SP[db][1], o); }
#pragma unroll
                for (int tb2 = 0; tb2 <= tb; ++tb2) {
                    f32x16 pt;
#pragma unroll
                    for (int i = 0; i < 16; ++i) pt[i] = 0.f;
#pragma unroll
                    for (int s = 0; s < 8; ++s) pt = GLA_MFMA(row_frag(imgK, 32 * tb2 + r32, s, hh), Qf[s], pt);
                    if (tb2 == tb) {
#pragma unroll
                        for (int i = 0; i < 16; ++i) pt[i] = (crow(i, hh) <= r32) ? pt[i] : 0.f;
                    }
                    o = GLA_MFMA(pack8(pt, 0), Vf[2 * tb2], o); o = GLA_MFMA(pack8(pt, 1), Vf[2 * tb2 + 1], o);
                }
#pragma unroll
                for (int i = 0; i < 16; ++i) Ot[(32 * tb + crow(i, hh)) * OP + 32 * wave + r32] = o[i];
            }
        }
        if (PASS) {
#pragma unroll
            for (int k = 0; k < 8; ++k) gpre[k] = *(const GAS unsigned long long*)(U + (m0 + 8 * wave + (lane >> 3)) * LDU + UG + h * 256 + 4 * (lane & 7) + 32 * k);
            if (c4 < 3) GLA_LOAD_B(m0 + 64);
        }
#pragma unroll
        for (int db = 0; db < 4; ++db) {
#pragma unroll
            for (int g4 = 0; g4 < 4; ++g4) { const f32x4 gv = *(const LAS f32x4*)(gc + 32 * db + 8 * g4 + 4 * hh);
                St[db][4 * g4 + 0] *= gv.x; St[db][4 * g4 + 1] *= gv.y; St[db][4 * g4 + 2] *= gv.z; St[db][4 * g4 + 3] *= gv.w; }
#pragma unroll
            for (int ks = 0; ks < 4; ++ks) St[db] = GLA_MFMA(tr_frag(imgL, lane, db, ks), Vf[ks], St[db]);
        }
        GLA_BAR();
        { int l3 = lane_o; asm volatile("" : "+v"(l3)); lane_s = l3; }
        if (c4 < 3) GLA_LOAD_V(m0 + 64);
        if (PASS) {
            const int t = 8 * wave + (lane >> 3), e0 = 4 * (lane & 7);
            f32x4 ov[8]; float ss = 0.f;
#pragma unroll
            for (int k = 0; k < 8; ++k) { ov[k] = *(const LAS f32x4*)(Ot + t * OP + e0 + 32 * k); ss += (ov[k].x * ov[k].x + ov[k].y * ov[k].y) + (ov[k].z * ov[k].z + ov[k].w * ov[k].w); }
            ss += __shfl_xor(ss, 1); ss += __shfl_xor(ss, 2); ss += __shfl_xor(ss, 4);
            const float rn = 1.0f / sqrtf(ss * (1.0f / 256.0f) + EPS);
#pragma unroll
            for (int k = 0; k < 8; ++k) { const f32x4 gh = *(const GAS f32x4*)(g_head + e0 + 32 * k); const unsigned long long gw = gpre[k];
                const float ga = bf_lo((unsigned)gw), gb = bf_hi((unsigned)gw), gcc = bf_lo((unsigned)(gw >> 32)), gd = bf_hi((unsigned)(gw >> 32));
                const float v0 = ov[k].x * rn * gh.x * (ga / (1.0f + __expf(-ga))), v1 = ov[k].y * rn * gh.y * (gb / (1.0f + __expf(-gb)));
                const float v2 = ov[k].z * rn * gh.z * (gcc / (1.0f + __expf(-gcc))), v3 = ov[k].w * rn * gh.w * (gd / (1.0f + __expf(-gd)));
                *(GAS unsigned long long*)(MIXIN + (m0 + t) * DM + h * 256 + e0 + 32 * k) = (unsigned long long)cvtpk(v0, v1) | ((unsigned long long)cvtpk(v2, v3) << 32); }
        }
    }
#undef lane
#undef tid
#undef GLA_LOAD_QK
#undef GLA_LOAD_V
#undef GLA_LOAD_B
    if (!PASS) {
#pragma unroll
        for (int db = 0; db < 4; ++db)
#pragma unroll
            for (int i = 0; i < 16; ++i) DS[(size_t)it * 32768 + (size_t)(32 * db + crow(i, hh0)) * 256 + 32 * wave + r320] = St[db][i];
        if (wave == 0) *(GAS f32x2_t*)(GS + (size_t)it * 128 + 2 * lane) = (f32x2_t){__builtin_amdgcn_exp2f(blsum[0]), __builtin_amdgcn_exp2f(blsum[1])};
    }
    __syncthreads();
}
__device__ __forceinline__ void scan(Frame& F, const Args& A) {
    PHASE_IDS();
    const int gtid = (int)blockIdx.x * (NWAVES * 64) + tid, nthreads = F.G * NWAVES * 64;
    const float* DS = (const float*)(A.ws + WS_DS); float* SIN = (float*)(A.ws + WS_SIN); const float* GS = (const float*)(A.ws + WS_GS);
    for (int idx = gtid; idx < 16 * 8192; idx += nthreads) {
        const int bh = idx >> 13, e4 = idx & 8191, d = e4 >> 6;
        f32x4 cur = (f32x4){0.f, 0.f, 0.f, 0.f};
#pragma unroll 4
        for (int s = 0; s < 16; ++s) { const size_t itx = (size_t)bh * 16 + s;
            *((GAS f32x4*)(SIN + itx * 32768) + e4) = cur;
            if (s < 15) { const float g = GS[itx * 128 + d]; const f32x4 dv = *((const GAS f32x4*)(DS + itx * 32768) + e4); cur = cur * g + dv; } }
    }
}
}
namespace sb {
using gla::f32x16; using gla::off_b; using gla::crow; using gla::tr_frag; using gla::row_frag; using gla::pack8; using gla::L2E;
constexpr float T2 = 25.0f * 1.4426950408889634f;
__device__ __forceinline__ void wave_item(Frame& F, const Args& A, int wi) {
    PHASE_IDS();
    const bf16* U = (const bf16*)(A.ws + WS_U); bf16* MIXIN = (bf16*)(A.ws + WS_MIXIN);
    const int hh0 = lane >> 5, r320 = lane & 31;
    const int kt0 = wi & 127, h = (wi >> 7) & 7, b = wi >> 10, t0 = 32 * kt0;
    LAS unsigned char* imgK = F.lds + wave * 16384; LAS unsigned char* imgV = imgK + 8192; LAS float* Of = (LAS float*)imgK;
    const size_t rowb = (size_t)b * SEQ;
    bf16x8 Qf[8];
#pragma unroll
    for (int s = 0; s < 8; ++s) Qf[s] = *(const GAS bf16x8*)(U + (rowb + t0 + r320) * LDU + USQ + h * 128 + 16 * s + 8 * hh0);
    f32x16 o[4];
#pragma unroll
    for (int c = 0; c < 4; ++c)
#pragma unroll
        for (int i = 0; i < 16; ++i) o[c][i] = 0.f;
    float R = 0.f;
    const float C = 0.08838834764831845f * L2E;
    v4u kx[8], vx[8];
#define SB_LOADK(KT) do { const int j0_ = 32 * (KT); _Pragma("unroll") for (int i = 0; i < 8; ++i) { const int n = lane + 64 * i, row = n >> 4, ch = n & 15; \
        kx[i] = *(const GAS v4u*)(U + (rowb + j0_ + row) * LDU + USK + h * 128 + 8 * ch); } } while (0)
#define SB_LOADV(KT) do { const int j0_ = 32 * (KT); _Pragma("unroll") for (int i = 0; i < 8; ++i) { const int n = lane + 64 * i, row = n >> 4, ch = n & 15; \
        vx[i] = *(const GAS v4u*)(U + (rowb + j0_ + row) * LDU + USV + h * 128 + 8 * ch); } } while (0)
    SB_LOADK(kt0);
    int lane_t = lane;
    for (int kt = kt0; kt >= 0; --kt) {
        { int lt = lane_o; asm volatile("" : "+v"(lt)); lane_t = lt; }
#define lane lane_t
        const int hh = lane >> 5, r32 = lane & 31;
#pragma unroll
        for (int i = 0; i < 8; ++i) { const int n = lane + 64 * i, row = n >> 4, ch = n & 15; *(LAS v4u*)(imgK + off_b(row, ch)) = kx[i]; }
        SB_LOADV(kt);
        f32x16 sacc;
#pragma unroll
        for (int i = 0; i < 16; ++i) sacc[i] = 0.f;
#pragma unroll
        for (int s = 0; s < 8; ++s) sacc = GLA_MFMA(row_frag(imgK, r32, s, hh), Qf[s], sacc);
        const bool diag = (kt == kt0);
        float lk[16], G[4], Gp[4];
#pragma unroll
        for (int i = 0; i < 16; ++i) { const float z2 = sacc[i] * C; const bool act = !diag || (crow(i, hh) < r32);
            const float sp = fmaxf(z2, 0.f) + __builtin_amdgcn_logf(1.0f + __builtin_amdgcn_exp2f(-fabsf(z2)));
            lk[i] = act ? -sp : 0.f; sacc[i] = act ? z2 : -3.0e38f; }
#pragma unroll
        for (int g = 0; g < 4; ++g) { G[g] = (lk[4 * g] + lk[4 * g + 1]) + (lk[4 * g + 2] + lk[4 * g + 3]); Gp[g] = __shfl_xor(G[g], 32); }
        float acc = R;
#pragma unroll
        for (int g = 3; g >= 0; --g) {
            const float offg = acc + (hh == 0 ? Gp[g] : 0.f);
            const float r3 = offg + lk[4 * g + 3], r2 = r3 + lk[4 * g + 2], r1 = r2 + lk[4 * g + 1], r0 = r1 + lk[4 * g];
            sacc[4 * g + 3] = __builtin_amdgcn_exp2f(sacc[4 * g + 3] + r3); sacc[4 * g + 2] = __builtin_amdgcn_exp2f(sacc[4 * g + 2] + r2);
            sacc[4 * g + 1] = __builtin_amdgcn_exp2f(sacc[4 * g + 1] + r1); sacc[4 * g] = __builtin_amdgcn_exp2f(sacc[4 * g] + r0);
            acc += G[g] + Gp[g];
        }
        R = acc;
#pragma unroll
        for (int i = 0; i < 8; ++i) { const int n = lane + 64 * i, row = n >> 4, ch = n & 15; *(LAS v4u*)(imgV + off_b(row, ch)) = vx[i]; }
        if (kt > 0) SB_LOADK(kt - 1);
        const bf16x8 w0 = pack8(sacc, 0), w1 = pack8(sacc, 1);
#pragma unroll
        for (int c = 0; c < 4; ++c) { o[c] = GLA_MFMA(w0, tr_frag(imgV, lane, c, 0), o[c]); o[c] = GLA_MFMA(w1, tr_frag(imgV, lane, c, 1), o[c]); }
        if (__ballot(R > -T2) == 0ull) break;
    }
#undef lane
#undef SB_LOADK
#undef SB_LOADV
#pragma unroll
    for (int c = 0; c < 4; ++c)
#pragma unroll
        for (int i = 0; i < 16; ++i) Of[crow(i, hh0) * 128 + 32 * c + r320] = o[c][i];
#pragma unroll
    for (int pz = 0; pz < 8; ++pz) { const int row = 4 * pz + (lane >> 4), c8 = 8 * (lane & 15);
        const f32x4 a = *(const LAS f32x4*)(Of + row * 128 + c8), bq = *(const LAS f32x4*)(Of + row * 128 + c8 + 4);
        const v4u gw = *(const GAS v4u*)(U + (rowb + t0 + row) * LDU + USG + h * 128 + c8);
        const float ov[8] = {a.x, a.y, a.z, a.w, bq.x, bq.y, bq.z, bq.w}; const unsigned gws[4] = {gw.x, gw.y, gw.z, gw.w}; unsigned ow[4];
#pragma unroll
        for (int q = 0; q < 4; ++q) { const float g0 = bf_lo(gws[q]), g1 = bf_hi(gws[q]);
            ow[q] = gla::cvtpk(ov[2 * q] * (g0 / (1.0f + __expf(-g0))), ov[2 * q + 1] * (g1 / (1.0f + __expf(-g1)))); }
        v4u w; w.x = ow[0]; w.y = ow[1]; w.z = ow[2]; w.w = ow[3];
        *(GAS v4u*)(MIXIN + (rowb + t0 + row) * DM + 1024 + h * 128 + c8) = w; }
}
}

__device__ __forceinline__ void p0_prologue(Frame& F, const Args& A) {
    PHASE_IDS();
    const float* x = A.in[0]; const float* p = A.in[1]; const float* g_pre = A.in[2]; const float* w_in = A.in[3];
    const float* w_out = A.in[7]; const float* w_g = A.in[9]; const float* w_p = A.in[11];
    unsigned char* ws = A.ws;
    bf16* WinT = (bf16*)(ws + WS_WIN); bf16* WoutT = (bf16*)(ws + WS_WOUT); bf16* WgT = (bf16*)(ws + WS_WG); bf16* WpT = (bf16*)(ws + WS_WP);
    bf16* XB = (bf16*)(ws + WS_XB); bf16* PIN = (bf16*)(ws + WS_PIN); float* RS = (float*)(ws + WS_RS); float* GLR = (float*)(ws + WS_GLR);
    LAS float* scr = (LAS float*)(F.lds + RING_OFF + wave * 16640);
    const int gw = F.vcu * NWAVES + wave, NGW = F.G * NWAVES;
    for (int repa = 0; repa < REP0A; ++repa) {
    constexpr int I_IN = (DM / 64) * (LDU / 64), I_SQ = (DM / 64) * (DM / 64), I_P = (PLE / 64) * (DM / 64);
    constexpr int NITEMS = I_IN + 2 * I_SQ + I_P;
    for (int it = gw; it < NITEMS; it += NGW) {
        int r = it;
        if (r < I_IN) { const int ng = LDU / 64, kb = r / ng, g = r % ng, nd = 64 * g; p0_item64(w_in, DIN_SRC, DM, WinT, nd + (nd >= 3072 ? 16 : 0), nd, 64 * kb, g_pre, scr, lane); continue; }
        r -= I_IN;
        if (r < I_SQ) { const int ng = DM / 64, kb = r / ng, g = r % ng; p0_item64(w_out, DM, DM, WoutT, 64 * g, 64 * g, 64 * kb, nullptr, scr, lane); continue; }
        r -= I_SQ;
        if (r < I_SQ) { const int ng = DM / 64, kb = r / ng, g = r % ng; p0_item64(w_g, DM, DM, WgT, 64 * g, 64 * g, 64 * kb, nullptr, scr, lane); continue; }
        r -= I_SQ;
        { const int ng = DM / 64, kb = r / ng, g = r % ng; p0_item64(w_p, DM, PLE, WpT, 64 * g, 64 * g, 64 * kb, nullptr, scr, lane); }
    }
    for (int m = gw; m < M; m += NGW) {
        const f32x4 v = *((const GAS f32x4*)(p + (size_t)m * PLE) + lane);
        *((GAS unsigned long long*)(PIN + (size_t)m * PLE) + lane) = (unsigned long long)pk2(v.x, v.y) | ((unsigned long long)pk2(v.z, v.w) << 32);
    }
    }
    for (int repb = 0; repb < REP0B; ++repb)
    {
        LAS v4u* tab = (LAS v4u*)(F.lds + P0_TAB_OFF); LAS float* part = (LAS float*)(F.lds + P0_PART_OFF);
        __syncthreads();
        for (int e = tid; e < 64 * 64; e += NWAVES * 64) { const int kb = e >> 6, ln = e & 63, k0 = 32 * kb + 8 * (ln >> 4), n = ln & 15; float wv[8];
#pragma unroll
            for (int jj = 0; jj < 8; ++jj) wv[jj] = w_in[(size_t)(k0 + jj) * DIN_SRC + 3072 + n] * g_pre[k0 + jj];
            v4u o; o.x = pk2(wv[0], wv[1]); o.y = pk2(wv[2], wv[3]); o.z = pk2(wv[4], wv[5]); o.w = pk2(wv[6], wv[7]); tab[e] = o; }
        __syncthreads();
        for (int rb = F.vcu; rb < M / 64; rb += F.G) {
            const int rg = wave & 3, kh = wave >> 2, row = 64 * rb + 16 * rg + (lane & 15), kq = lane >> 4;
            const GAS f32x4* xr = (const GAS f32x4*)(x + (size_t)row * DM + 1024 * kh + 8 * kq);
            GAS v4u* xo = (GAS v4u*)(XB + (size_t)row * DM + 1024 * kh + 8 * kq);
            f32x4 acc = (f32x4){0.f, 0.f, 0.f, 0.f}; float ss = 0.f;
#pragma unroll 8
            for (int kb = 0; kb < 32; ++kb) {
                const f32x4 a = xr[8 * kb], c = xr[8 * kb + 1];
                ss += (a.x * a.x + a.y * a.y) + (a.z * a.z + a.w * a.w) + (c.x * c.x + c.y * c.y) + (c.z * c.z + c.w * c.w);
                v4u pa; pa.x = gla::cvtpk(a.x, a.y); pa.y = gla::cvtpk(a.z, a.w); pa.z = gla::cvtpk(c.x, c.y); pa.w = gla::cvtpk(c.z, c.w);
                xo[4 * kb] = pa;
                const v4u pb = tab[(32 * kh + kb) * 64 + lane];
                acc = __builtin_amdgcn_mfma_f32_16x16x32_bf16(__builtin_bit_cast(bf16x8, pa), __builtin_bit_cast(bf16x8, pb), acc, 0, 0, 0);
            }
            ss += __shfl_xor(ss, 16); ss += __shfl_xor(ss, 32);
            if (kh == 1) { LAS float* pp = part + (rg * 64 + lane) * 5; pp[0] = acc[0]; pp[1] = acc[1]; pp[2] = acc[2]; pp[3] = acc[3]; pp[4] = ss; }
            __syncthreads();
            if (kh == 0) { const LAS float* pp = part + (rg * 64 + lane) * 5; acc[0] += pp[0]; acc[1] += pp[1]; acc[2] += pp[2]; acc[3] += pp[3]; ss += pp[4];
                const float r = 1.0f / sqrtf(ss * (1.0f / DM) + EPS);
#pragma unroll
                for (int q = 0; q < 4; ++q) { const float rq = __shfl(r, 4 * kq + q); GLR[(size_t)(64 * rb + 16 * rg + 4 * kq + q) * 16 + (lane & 15)] = acc[q] * rq; }
                if (lane < 16) RS[64 * rb + 16 * rg + lane] = r; }
            __syncthreads();
        }
    }
}

__device__ __forceinline__ void p5_postnorm(Frame& F, const Args& A) {
    PHASE_IDS();
    const float* g_post = A.in[8]; const bf16* mixb = (const bf16*)(A.ws + WS_MIX); bf16* HB = (bf16*)(A.ws + WS_XB);
    const int gw = F.vcu * NWAVES + wave, NGW = F.G * NWAVES;
    f32x4 ga[4], gb[4];
#pragma unroll
    for (int j = 0; j < 4; ++j) { ga[j] = *((const GAS f32x4*)g_post + 2 * lane + 128 * j); gb[j] = *((const GAS f32x4*)g_post + 2 * lane + 128 * j + 1); }
    for (int m = gw; m < M; m += NGW) {
        const GAS v4u* mr = (const GAS v4u*)(mixb + (size_t)m * DM) + lane;
        GAS v4u* hr = (GAS v4u*)(HB + (size_t)m * DM) + lane;
        v4u mv[4], xv[4]; float ss = 0.f;
#pragma unroll
        for (int j = 0; j < 4; ++j) { mv[j] = mr[64 * j]; xv[j] = hr[64 * j]; }
        float mf[4][8];
#pragma unroll
        for (int j = 0; j < 4; ++j) { const unsigned w4[4] = {mv[j].x, mv[j].y, mv[j].z, mv[j].w};
#pragma unroll
            for (int q = 0; q < 4; ++q) { mf[j][2 * q] = bf_lo(w4[q]); mf[j][2 * q + 1] = bf_hi(w4[q]); ss += mf[j][2 * q] * mf[j][2 * q] + mf[j][2 * q + 1] * mf[j][2 * q + 1]; } }
        ss = wave_sum(ss); const float r = 1.0f / sqrtf(ss * (1.0f / DM) + EPS);
#pragma unroll
        for (int j = 0; j < 4; ++j) { const unsigned x4[4] = {xv[j].x, xv[j].y, xv[j].z, xv[j].w};
            v4u o; o.x = gla::cvtpk(bf_lo(x4[0]) + mf[j][0] * r * ga[j].x, bf_hi(x4[0]) + mf[j][1] * r * ga[j].y); o.y = gla::cvtpk(bf_lo(x4[1]) + mf[j][2] * r * ga[j].z, bf_hi(x4[1]) + mf[j][3] * r * ga[j].w);
            o.z = gla::cvtpk(bf_lo(x4[2]) + mf[j][4] * r * gb[j].x, bf_hi(x4[2]) + mf[j][5] * r * gb[j].y); o.w = gla::cvtpk(bf_lo(x4[3]) + mf[j][6] * r * gb[j].z, bf_hi(x4[3]) + mf[j][7] * r * gb[j].w);
            hr[64 * j] = o; }
    }
}

__global__ void __launch_bounds__(NWAVES * 64, 2) fwd_megakernel(Args args) {
    extern __shared__ __attribute__((aligned(16))) unsigned char lds[];
    Frame F;
    F.lds = (LAS unsigned char*)lds;
    F.MISC = (volatile LAS unsigned*)(F.lds + MISC_OFF);
    F.wave = __builtin_amdgcn_readfirstlane(threadIdx.x >> 6);
    F.G = gridDim.x; { const int bx = blockIdx.x; F.vcu = (F.G % 8 == 0) ? (bx % 8) * (F.G / 8) + bx / 8 : bx; }
    unsigned char* ws = args.ws;
    F.ctl = (gu32*)(ws + WS_CTL);
    for (int u = threadIdx.x; u < (LDS_BYTES - LDSCTL_OFF) / 4; u += NWAVES * 64) ((LAS unsigned*)(F.lds + LDSCTL_OFF))[u] = 0u;
    __syncthreads();
    XcdBarrier bar = xcd_barrier_post((unsigned*)(F.ctl + CW_BAR), F.MISC + 8);

    bf16* WinT = (bf16*)(ws + WS_WIN); bf16* WoutT = (bf16*)(ws + WS_WOUT); bf16* WgT = (bf16*)(ws + WS_WG); bf16* WpT = (bf16*)(ws + WS_WP);
    bf16* XB = (bf16*)(ws + WS_XB); bf16* PIN = (bf16*)(ws + WS_PIN); float* RS = (float*)(ws + WS_RS);
    bf16* U = (bf16*)(ws + WS_U); bf16* PB = (bf16*)(ws + WS_PB); bf16* MIXIN = (bf16*)(ws + WS_MIXIN);

    for (int rep = 0; rep < REP0; ++rep) {
    p0_prologue(F, args);
    xcd_barrier(bar); }
    for (int rep = 0; rep < REP1; ++rep) {
    { pg8::Gemm g{XB, WinT, M, LDU, DM}; pg8::StaticOrder S; S.init(M, LDU, F.G, (int)blockIdx.x);
      pg8::EpiB16 E{U, LDU, RS};
      pg8::gemm_phase<pg8::EpiB16, pg8::StaticOrder, G_ALIGN, G_SP2>(F.lds + RING_OFF, g, S, E, F.wave); }
    xcd_barrier(bar); }
    for (int rep = 0; rep < REP2; ++rep) {
    for (int r2 = 0; r2 < REP2A; ++r2)
    for (int it = (int)blockIdx.x; it < BATCH * GH * 16; it += F.G) gla::item<0>(F, args, it);
    { const int gw = (int)blockIdx.x * NWAVES + F.wave, NGW = F.G * NWAVES;
      for (int r2 = 0; r2 < REP2B; ++r2)
      for (int wi = gw; wi < BATCH * SH * (SEQ / 32); wi += NGW) sb::wave_item(F, args, wi); }
    xcd_barrier(bar); }
    for (int rep = 0; rep < REP3; ++rep) {
    for (int r3 = 0; r3 < REP3A; ++r3) {
    gla::scan(F, args);
    xcd_barrier(bar); }
    for (int it = (int)blockIdx.x; it < BATCH * GH * 16; it += F.G) gla::item<1>(F, args, it);
    xcd_barrier(bar); }
    for (int rep = 0; rep < REP4; ++rep) {
    { pg8::Gemm g{MIXIN, WoutT, M, DM, DM}; pg8::StaticOrder S; S.init(M, DM, F.G, (int)blockIdx.x);
      pg8::EpiB16 E{(bf16*)(ws + WS_MIX), DM, nullptr};
      pg8::gemm_phase<pg8::EpiB16, pg8::StaticOrder, G_ALIGN, G_SP2>(F.lds + RING_OFF, g, S, E, F.wave); }
    { pg8::Gemm g{PIN, WpT, M, DM, PLE}; pg8::StaticOrder S; S.init(M, DM, F.G, (int)blockIdx.x);
      pg8::EpiB16 E{PB, DM, nullptr};
      pg8::gemm_phase<pg8::EpiB16, pg8::StaticOrder, G_ALIGN, G_SP2>(F.lds + RING_OFF, g, S, E, F.wave); }
    xcd_barrier(bar); }
    for (int rep = 0; rep < REP5; ++rep) {
    p5_postnorm(F, args);
    xcd_barrier(bar); }
    for (int rep = 0; rep < REP6; ++rep)
    { pg8::Gemm g{XB, WgT, M, DM, DM}; pg8::StaticOrder S; S.init(M, DM, F.G, (int)blockIdx.x);
      pg8::EpiFinal E{XB, args.out, PB, args.in[10], DM};
      pg8::gemm_phase<pg8::EpiFinal, pg8::StaticOrder, G_ALIGN, G_SP2>(F.lds + RING_OFF, g, S, E, F.wave); }
}

extern "C" void kernel_launch(void* const* d_in, const int* in_sizes, int n_in, void* d_out, int out_size, void* d_ws, size_t ws_size, hipStream_t stream) {
    static int grid = 0;
    if (grid == 0) {
        if (n_in != 12 || in_sizes[0] != M * DM || out_size != M * DM || ws_size < WS_END) { fprintf(stderr, "kernel_launch: unexpected shapes: n_in %d in0 %d out %d ws %zu (need %zu)\n", n_in, n_in > 0 ? in_sizes[0] : -1, out_size, ws_size, (size_t)WS_END); grid = -1; return; }
        int dev = 0, cus = 0, per_cu = 0;
        if (hipGetDevice(&dev) != hipSuccess || hipDeviceGetAttribute(&cus, hipDeviceAttributeMultiprocessorCount, dev) != hipSuccess) { grid = -1; return; }
        if (hipFuncSetAttribute((const void*)fwd_megakernel, hipFuncAttributeMaxDynamicSharedMemorySize, LDS_BYTES) != hipSuccess) { fprintf(stderr, "kernel_launch: hipFuncSetAttribute failed\n"); grid = -1; return; }
        if (hipOccupancyMaxActiveBlocksPerMultiprocessor(&per_cu, (const void*)fwd_megakernel, NWAVES * 64, LDS_BYTES) != hipSuccess || per_cu < 1)
            fprintf(stderr, "kernel_launch: note: occupancy query reports %d workgroups per CU\n", per_cu);
        (void)hipGetLastError();
        grid = cus;
    }
    if (grid < 0) return;
    if (hipMemsetAsync((char*)d_ws + WS_CTL, 0, CTL_ZERO_BYTES, stream) != hipSuccess) { fprintf(stderr, "kernel_launch: hipMemsetAsync failed\n"); return; }
    Args a{};
    for (int i = 0; i < 12; ++i) a.in[i] = (const float*)d_in[i];
    a.out = (float*)d_out; a.ws = (unsigned char*)d_ws;
    hipLaunchKernelGGL(fwd_megakernel, dim3(grid), dim3(NWAVES * 64), LDS_BYTES, stream, a);
    const hipError_t le = hipPeekAtLastError();
    if (le != hipSuccess) fprintf(stderr, "kernel_launch: launch failed: %s\n", hipGetErrorName(le));
}
```
